# Optimizing an MI355X kernel written in HIP

```python
import jax, jax.numpy as jnp
from jax import lax
import numpy as np

D_MODEL = 2048
BATCH = 2
SEQ = 8192
DEPTH = 4

HEAD_DIM = 64
HALF_DIM = HEAD_DIM // 2
N_MIXERS = 4
N_HEADS_PER_MIXER = 8
MIX_WIDTH = N_MIXERS * N_HEADS_PER_MIXER * HEAD_DIM
IN_COLS = 4 * MIX_WIDTH + N_HEADS_PER_MIXER
N_QK_NORMED = 3
ROPE_THETA = 10000.0
RMS_EPS = 1e-6
Q_BLOCK = 128
DILATED_SEGMENTS = ((128, 1), (512, 4), (2048, 16))
MOBA_BLOCK = 256
MOBA_TOPK = 3
MOBA_Q_CHUNK = 64
NEG = -1e30
SCALE = HEAD_DIM ** -0.5

kernel_name = "hybrid_parallel_heads_dilated_stickbreak_moba_fox"


def rms_norm(x, g):
    xf = x.astype(jnp.float32)
    y = xf * lax.rsqrt(jnp.mean(xf * xf, axis=-1, keepdims=True) + RMS_EPS)
    return y * g.astype(jnp.float32)


def head_rms_norm(t, g):
    return t * lax.rsqrt(jnp.mean(t * t, axis=-1, keepdims=True) + RMS_EPS) * g.astype(jnp.float32)


def rope_tables(seq):
    inv = 1.0 / (ROPE_THETA ** (jnp.arange(0, HEAD_DIM, 2, dtype=jnp.float32) / HEAD_DIM))
    ang = jnp.arange(seq, dtype=jnp.float32)[:, None] * inv[None, :]
    return jnp.cos(ang), jnp.sin(ang)


def apply_rope(t, cos, sin):
    t1, t2 = t[..., :HALF_DIM], t[..., HALF_DIM:]
    return jnp.concatenate([t1 * cos - t2 * sin, t2 * cos + t1 * sin], axis=-1)


def banded_attention(q, k, v, span):
    L = q.shape[-2]
    lead = q.shape[:-2]
    nb = -(-L // Q_BLOCK)
    Lp = nb * Q_BLOCK
    pad = [(0, 0)] * len(lead) + [(0, Lp - L), (0, 0)]
    q, k, v = (jnp.pad(t, pad) for t in (q, k, v))
    qb = q.reshape(*lead, nb, Q_BLOCK, HEAD_DIM)
    kb = k.reshape(*lead, nb, Q_BLOCK, HEAD_DIM)
    vb = v.reshape(*lead, nb, Q_BLOCK, HEAD_DIM)
    zero = jnp.zeros_like(kb[..., :1, :, :])
    kwin = jnp.concatenate([jnp.concatenate([zero, kb[..., :-1, :, :]], axis=-3), kb], axis=-2)
    vwin = jnp.concatenate([jnp.concatenate([zero, vb[..., :-1, :, :]], axis=-3), vb], axis=-2)
    s = jnp.einsum('...nqd,...nkd->...nqk', qb, kwin) * SCALE
    blk = jnp.arange(nb)[:, None]
    qpos = blk * Q_BLOCK + jnp.arange(Q_BLOCK)[None, :]
    kpos = (blk - 1) * Q_BLOCK + jnp.arange(2 * Q_BLOCK)[None, :]
    dist = qpos[:, :, None] - kpos[:, None, :]
    mask = (dist >= 0) & (dist <= span) & (kpos[:, None, :] >= 0)
    s = jnp.where(mask, s, NEG)
    lse = jax.nn.logsumexp(s, axis=-1)
    p = jnp.exp(s - lse[..., None])
    o = jnp.einsum('...nqk,...nkd->...nqd', p, vwin)
    return o.reshape(*lead, Lp, HEAD_DIM)[..., :L, :], lse.reshape(*lead, Lp)[..., :L]


def dilated_attention(q, k, v):
    bsz, nh, seq, hd = q.shape
    outs, lses = [], []
    for window, dil in DILATED_SEGMENTS:
        L = seq // dil
        sub = lambda t: t.reshape(bsz, nh, L, dil, hd).swapaxes(2, 3)
        o, lse = banded_attention(sub(q), sub(k), sub(v), window // dil)
        outs.append(o.swapaxes(2, 3).reshape(bsz, nh, seq, hd))
        lses.append(lse.swapaxes(2, 3).reshape(bsz, nh, seq))
    w = jax.nn.softmax(jnp.stack(lses, axis=0), axis=0)
    return sum(w[i][..., None] * outs[i] for i in range(len(outs)))


def stick_breaking_attention(q, k, v):
    bsz, nh, seq, hd = q.shape
    kpos = jnp.arange(seq)

    def block(i):
        qi = lax.dynamic_slice_in_dim(q, i * Q_BLOCK, Q_BLOCK, axis=2)
        z = jnp.einsum('bhqd,bhkd->bhqk', qi, k) * SCALE
        qpos = i * Q_BLOCK + jnp.arange(Q_BLOCK)
        causal = kpos[None, :] < qpos[:, None]
        log_1mb = jnp.where(causal, jax.nn.log_sigmoid(-z), 0.0)
        after = lax.cumsum(log_1mb, axis=3, reverse=True) - log_1mb
        log_a = jnp.where(causal, jax.nn.log_sigmoid(z) + after, NEG)
        return jnp.einsum('bhqk,bhkd->bhqd', jnp.exp(log_a), v)

    out = lax.map(block, jnp.arange(seq // Q_BLOCK))
    return out.transpose(1, 2, 0, 3, 4).reshape(bsz, nh, seq, hd)


def moba_attention(q, k, v):
    bsz, nh, seq, hd = q.shape
    nblk = -(-seq // MOBA_BLOCK)
    sp = nblk * MOBA_BLOCK
    pad = [(0, 0), (0, 0), (0, sp - seq), (0, 0)]
    kb = jnp.pad(k, pad).reshape(bsz, nh, nblk, MOBA_BLOCK, hd)
    vb = jnp.pad(v, pad).reshape(bsz, nh, nblk, MOBA_BLOCK, hd)
    kmean = jnp.mean(kb, axis=3)
    topk = min(MOBA_TOPK, nblk)
    b_idx = jnp.arange(bsz)[:, None, None, None]
    h_idx = jnp.arange(nh)[None, :, None, None]
    blk_ids = jnp.arange(nblk)

    def chunk(i):
        start = i * MOBA_Q_CHUNK
        qi = lax.dynamic_slice_in_dim(q, start, MOBA_Q_CHUNK, axis=2)
        qpos = start + jnp.arange(MOBA_Q_CHUNK)
        qblk = qpos // MOBA_BLOCK
        gate = jnp.einsum('bhqd,bhnd->bhqn', qi, kmean)
        gate = jnp.where(blk_ids[None, :] < qblk[:, None], gate, NEG)
        _, sel = lax.top_k(gate, topk)
        valid = sel < qblk[None, None, :, None]
        ks = kb[b_idx, h_idx, sel]
        vs = vb[b_idx, h_idx, sel]
        s_sel = jnp.einsum('bhqd,bhqnkd->bhqnk', qi, ks) * SCALE
        s_sel = jnp.where(valid[..., None], s_sel, NEG).reshape(bsz, nh, MOBA_Q_CHUNK, topk * MOBA_BLOCK)
        own = start // MOBA_BLOCK
        k_own = lax.dynamic_index_in_dim(kb, own, axis=2, keepdims=False)
        v_own = lax.dynamic_index_in_dim(vb, own, axis=2, keepdims=False)
        s_own = jnp.einsum('bhqd,bhkd->bhqk', qi, k_own) * SCALE
        own_pos = own * MOBA_BLOCK + jnp.arange(MOBA_BLOCK)
        s_own = jnp.where(own_pos[None, :] <= qpos[:, None], s_own, NEG)
        p = jax.nn.softmax(jnp.concatenate([s_sel, s_own], axis=-1), axis=-1)
        p_sel = p[..., :topk * MOBA_BLOCK].reshape(bsz, nh, MOBA_Q_CHUNK, topk, MOBA_BLOCK)
        p_own = p[..., topk * MOBA_BLOCK:]
        return (jnp.einsum('bhqnk,bhqnkd->bhqd', p_sel, vs)
                + jnp.einsum('bhqk,bhkd->bhqd', p_own, v_own))

    out = lax.map(chunk, jnp.arange(seq // MOBA_Q_CHUNK))
    return out.transpose(1, 2, 0, 3, 4).reshape(bsz, nh, seq, hd)


def forgetting_attention(q, k, v, log_f):
    bsz, nh, seq, hd = q.shape
    cum = lax.cumsum(log_f, axis=2)
    kpos = jnp.arange(seq)

    def block(i):
        qi = lax.dynamic_slice_in_dim(q, i * Q_BLOCK, Q_BLOCK, axis=2)
        fi = lax.dynamic_slice_in_dim(cum, i * Q_BLOCK, Q_BLOCK, axis=2)
        s = jnp.einsum('bhqd,bhkd->bhqk', qi, k) * SCALE + fi[..., :, None] - cum[..., None, :]
        qpos = i * Q_BLOCK + jnp.arange(Q_BLOCK)
        s = jnp.where(kpos[None, :] <= qpos[:, None], s, NEG)
        return jnp.einsum('bhqk,bhkd->bhqd', jax.nn.softmax(s, axis=-1), v)

    out = lax.map(block, jnp.arange(seq // Q_BLOCK))
    return out.transpose(1, 2, 0, 3, 4).reshape(bsz, nh, seq, hd)


def setup_inputs(seed: int = 0) -> dict:
    key = jax.random.key(seed)
    ks = jax.random.split(key, 7)
    x = jax.random.normal(ks[0], (BATCH, SEQ, D_MODEL), jnp.float32)
    norm_gain = 1.0 + 0.02 * jax.random.normal(ks[1], (DEPTH, D_MODEL), jnp.float32)
    w_in = jax.random.normal(ks[2], (DEPTH, D_MODEL, IN_COLS), jnp.float32) * D_MODEL ** -0.5
    q_norm_gain = 1.0 + 0.02 * jax.random.normal(ks[3], (DEPTH, N_QK_NORMED, HEAD_DIM), jnp.float32)
    k_norm_gain = 1.0 + 0.02 * jax.random.normal(ks[4], (DEPTH, N_QK_NORMED, HEAD_DIM), jnp.float32)
    forget_bias = jax.random.uniform(ks[5], (DEPTH, N_HEADS_PER_MIXER), jnp.float32, 1.0, 5.0)
    w_out = jax.random.normal(ks[6], (DEPTH, MIX_WIDTH, D_MODEL), jnp.float32) * MIX_WIDTH ** -0.5
    return {"x": x, "norm_gain": norm_gain, "w_in": w_in, "q_norm_gain": q_norm_gain,
            "k_norm_gain": k_norm_gain, "forget_bias": forget_bias, "w_out": w_out}


def reference(x, norm_gain, w_in, q_norm_gain, k_norm_gain, forget_bias, w_out):
    bsz, seq, _ = x.shape
    cos, sin = rope_tables(seq)
    for layer in range(DEPTH):
        h = rms_norm(x, norm_gain[layer])
        proj = jnp.einsum('bsd,dc->bsc', h, w_in[layer].astype(jnp.float32))
        qkv = proj[..., :3 * MIX_WIDTH].reshape(bsz, seq, 3, N_MIXERS, N_HEADS_PER_MIXER, HEAD_DIM)
        qkv = qkv.transpose(2, 3, 0, 4, 1, 5)
        q, k, v = qkv[0], qkv[1], qkv[2]
        gate = proj[..., 3 * MIX_WIDTH:4 * MIX_WIDTH]
        log_f = jax.nn.log_sigmoid(proj[..., 4 * MIX_WIDTH:]
                                   + forget_bias[layer].astype(jnp.float32)).transpose(0, 2, 1)
        qn, kn = q_norm_gain[layer], k_norm_gain[layer]
        o_a = dilated_attention(apply_rope(head_rms_norm(q[0], qn[0]), cos, sin),
                                apply_rope(head_rms_norm(k[0], kn[0]), cos, sin), v[0])
        o_b = stick_breaking_attention(q[1], k[1], v[1])
        o_c = moba_attention(apply_rope(head_rms_norm(q[2], qn[1]), cos, sin),
                             apply_rope(head_rms_norm(k[2], kn[1]), cos, sin), v[2])
        o_d = forgetting_attention(head_rms_norm(q[3], qn[2]), head_rms_norm(k[3], kn[2]), v[3], log_f)
        y = jnp.stack([o_a, o_b, o_c, o_d], axis=1)
        y = y.transpose(0, 3, 1, 2, 4).reshape(bsz, seq, MIX_WIDTH)
        y = y * jax.nn.silu(gate)
        x = x + jnp.einsum('bsc,cd->bsd', y, w_out[layer].astype(jnp.float32)).astype(x.dtype)
    return x
```

```cpp
#include <hip/hip_runtime.h>
#include <hip/hip_cooperative_groups.h>
#include <cstdio>
#include <cstdint>
#include <cmath>
namespace cg = cooperative_groups;
namespace pg8 {
#define PG8_LAS __attribute__((address_space(3)))
typedef unsigned short bf16_t;
typedef short bf16x8 __attribute__((ext_vector_type(8)));
typedef float f32x4 __attribute__((ext_vector_type(4)));
typedef unsigned u32x4 __attribute__((ext_vector_type(4)));
constexpr int BM = 256, BK = 64, HALF = 128, HTB = HALF * BK * 2  , STAGE_BYTES = 8 * HTB, NXCD = 8, WGM = 8;

__host__ __device__ __forceinline__ int lds_byte(int r, int c) { const int st = (r >> 4) * 2 + (c >> 5), rr = r & 15, cc = c & 31, ob = rr * 64 + cc * 2; return st * 1024 + (ob ^ (((ob >> 9) & 1) << 5)); }
__host__ __device__ __forceinline__ void stage_rc(int b, int& R, int& C) { const int st = b / 1024, sb = b % 1024, swz = sb ^ (((sb >> 9) & 1) << 5); R = (st >> 1) * 16 + swz / 64; C = (st & 1) * 32 + (swz % 64) / 2; }
__host__ __device__ __forceinline__ int perm32(int rho) { const int n = rho >> 4, i = rho & 15; return 8 * (i >> 2) + 4 * n + (i & 3); }

struct Unit { int pm, pn; };
struct Gemm { const bf16_t* A; const bf16_t* Bt; int M, N, K; };

struct StaticOrder {
    int nM, nN, nwg, G, c;
    __host__ __device__ void init(int M, int N, int G_, int c_) { nM = M / BM; nN = N / BM; nwg = nM * nN; G = G_; c = c_; }
    __host__ __device__ bool next(int i, Unit& u) const {
        const long L = (long)i * G + c; if (L >= nwg) return false;
        int wgid = (int)L; { const int q = nwg / NXCD, r = nwg % NXCD, xcd = wgid % NXCD, off = wgid / NXCD; wgid = (xcd < r ? xcd * (q + 1) : r * (q + 1) + (xcd - r) * q) + off; }
        const int nig = WGM * nN, gid = wgid / nig, fm = gid * WGM, gsz = (nM - fm) < WGM ? (nM - fm) : WGM;
        u.pm = fm + ((wgid % nig) % gsz); u.pn = (wgid % nig) / gsz; return true;
    }
    __device__ __forceinline__ void a_ready(const Unit&) const {}
    __device__ __forceinline__ void done(const Unit&) const {}
};

__device__ __forceinline__ unsigned cvt_pk_bf16(float lo, float hi) { unsigned r; asm volatile("v_cvt_pk_bf16_f32 %0, %1, %2" : "=v"(r) : "v"(lo), "v"(hi)); return r; }
typedef float f32x2 __attribute__((ext_vector_type(2)));
template <class Epi, class Sched, bool ALIGN_EPI = false, bool SP2 = false>
__device__ __forceinline__ void gemm_phase(PG8_LAS unsigned char* lds, const Gemm g, const Sched& S, const Epi& E) {
    int tid_ = threadIdx.x; asm volatile("" : "+v"(tid_));
    const int tid = tid_, wid = __builtin_amdgcn_readfirstlane(tid >> 6), lane = tid & 63, wr = wid >> 2, wc = wid & 3, fr = lane & 15, fq = lane >> 4;
    const int K = g.K, nt = K / BK;
    unsigned voffA[2], voffB[2];
#pragma unroll
    for (int i = 0; i < 2; ++i) { int R, C; stage_rc(tid * 16 + i * 8192, R, C); const int Rb = Epi::PERM ? ((R & ~31) + perm32(R & 31)) : R;
        voffA[i] = (unsigned)(R * K + C) * 2u; voffB[i] = (unsigned)(Rb * K + C) * 2u; }
    const size_t kstep = (size_t)(BK * 2);
    const size_t hstep = (size_t)HALF * K * 2;
    const size_t tstep = 2 * hstep;
    const unsigned ldsw = (unsigned)wid * 1024u;
    const int aoff = lds_byte(wr * 64 + fr, fq * 8), boff = lds_byte(wc * 32 + fr, fq * 8);
#define PG8_SA(b, h) (((b) * 2 + (h)) * HTB)
#define PG8_SB(b, h) ((4 + (b) * 2 + (h)) * HTB)
#define PG8_STAGE(bufoff, gbase, voff) do { _Pragma("unroll") for (int _i = 0; _i < 2; ++_i) \
        __builtin_amdgcn_global_load_lds((const unsigned*)((const char*)(gbase) + (voff)[_i]), (PG8_LAS unsigned*)(lds + (bufoff) + ldsw + _i * 8192), 16, 0, 0); } while (0)
#define PG8_LDA(dst, b, h) do { _Pragma("unroll") for (int m = 0; m < 4; ++m) _Pragma("unroll") for (int k = 0; k < 2; ++k) dst[m][k] = *(const PG8_LAS bf16x8*)(lds + PG8_SA(b, h) + aoff + m * 2048 + k * 1024); } while (0)
#define PG8_LDB(dst, b, h) do { _Pragma("unroll") for (int n = 0; n < 2; ++n) _Pragma("unroll") for (int k = 0; k < 2; ++k) dst[n][k] = *(const PG8_LAS bf16x8*)(lds + PG8_SB(b, h) + boff + n * 2048 + k * 1024); } while (0)
#define PG8_MMA(ai, bj, At, Bt) do { __builtin_amdgcn_s_setprio(1); _Pragma("unroll") for (int m = 0; m < 4; ++m) _Pragma("unroll") for (int n = 0; n < 2; ++n) _Pragma("unroll") for (int k = 0; k < 2; ++k) \
        acc[ai][bj][m][n] = __builtin_amdgcn_mfma_f32_16x16x32_bf16(Bt[n][k], At[m][k], acc[ai][bj][m][n], 0, 0, 0); __builtin_amdgcn_s_setprio(0); } while (0)
#define PG8_WAIT_V(n) asm volatile("s_waitcnt vmcnt(" #n ")" ::: "memory")
#define PG8_WAIT_L(n) asm volatile("s_waitcnt lgkmcnt(" #n ")" ::: "memory")
#define PG8_BAR __builtin_amdgcn_s_barrier()
#define PG8_SCHED __builtin_amdgcn_sched_barrier(0)
    Unit cur, nxt; int ui = 0;
    if (!S.next(0, cur)) return;
    f32x4 acc[2][2][4][2];
#pragma unroll
    for (int a = 0; a < 2; ++a)
#pragma unroll
        for (int b = 0; b < 2; ++b)
#pragma unroll
            for (int m = 0; m < 4; ++m)
#pragma unroll
                for (int n = 0; n < 2; ++n) acc[a][b][m][n] = (f32x4){0.f, 0.f, 0.f, 0.f};
    bf16x8 At[4][2], B0[2][2], B1[2][2];
    const char* cA = (const char*)g.A + (size_t)cur.pm * tstep; const char* cB = (const char*)g.Bt + (size_t)cur.pn * tstep;
    S.a_ready(cur);
    if constexpr (SP2) {
        PG8_STAGE(PG8_SB(0, 0), cB, voffB); PG8_STAGE(PG8_SB(0, 1), cB + hstep, voffB); PG8_STAGE(PG8_SA(0, 0), cA, voffA); PG8_STAGE(PG8_SA(0, 1), cA + hstep, voffA);
        if (wr == 1) PG8_BAR;
        PG8_WAIT_V(2); PG8_BAR;
        PG8_STAGE(PG8_SB(1, 0), cB + kstep, voffB); PG8_STAGE(PG8_SA(1, 0), cA + kstep, voffA); PG8_STAGE(PG8_SB(1, 1), cB + hstep + kstep, voffB);
        PG8_WAIT_V(6); PG8_BAR;
    } else {
        PG8_STAGE(PG8_SB(0, 0), cB, voffB); PG8_STAGE(PG8_SA(0, 0), cA, voffA); PG8_STAGE(PG8_SB(0, 1), cB + hstep, voffB); PG8_STAGE(PG8_SA(0, 1), cA + hstep, voffA);
        if (wr == 1) PG8_BAR;
        PG8_WAIT_V(4); PG8_BAR;
        PG8_STAGE(PG8_SB(1, 0), cB + kstep, voffB); PG8_STAGE(PG8_SA(1, 0), cA + kstep, voffA); PG8_STAGE(PG8_SB(1, 1), cB + hstep + kstep, voffB);
        PG8_WAIT_V(6); PG8_BAR;
    }
    for (;;) {
        const bool has_next = S.next(ui + 1, nxt);
        const char* nA = has_next ? (const char*)g.A + (size_t)nxt.pm * tstep : cA; const char* nB = has_next ? (const char*)g.Bt + (size_t)nxt.pn * tstep : cB;
        for (int t = 0; t < nt; t += 2) {
            const bool last = (t == nt - 2);
            const char* a1 = cA + (size_t)(t + 1) * kstep;
            const char* a2 = last ? nA : cA + (size_t)(t + 2) * kstep; const char* b2 = last ? nB : cB + (size_t)(t + 2) * kstep;
            const char* a3 = a2 + kstep; const char* b3 = b2 + kstep;
            if (last && has_next) S.a_ready(nxt);
            if constexpr (SP2) {
            PG8_LDB(B0, 0, 0); PG8_LDB(B1, 0, 1); PG8_SCHED; PG8_LDA(At, 0, 0); PG8_STAGE(PG8_SA(1, 1), a1 + hstep, voffA);
            PG8_WAIT_V(8); PG8_WAIT_L(0); PG8_BAR; PG8_MMA(0, 0, At, B0); PG8_MMA(0, 1, At, B1); PG8_BAR; PG8_SCHED;
            PG8_LDA(At, 0, 1); PG8_STAGE(PG8_SB(0, 0), b2, voffB); PG8_STAGE(PG8_SB(0, 1), b2 + hstep, voffB); PG8_STAGE(PG8_SA(0, 0), a2, voffA);
            PG8_WAIT_V(8); PG8_WAIT_L(0); PG8_BAR; PG8_MMA(1, 0, At, B0); PG8_MMA(1, 1, At, B1); PG8_BAR; PG8_SCHED;
            PG8_LDB(B0, 1, 0); PG8_LDB(B1, 1, 1); PG8_SCHED; PG8_LDA(At, 1, 0); PG8_STAGE(PG8_SA(0, 1), a2 + hstep, voffA);
            PG8_WAIT_V(8); PG8_WAIT_L(0); PG8_BAR; PG8_MMA(0, 0, At, B0); PG8_MMA(0, 1, At, B1); PG8_BAR; PG8_SCHED;
            PG8_LDA(At, 1, 1); PG8_STAGE(PG8_SB(1, 0), b3, voffB); PG8_STAGE(PG8_SB(1, 1), b3 + hstep, voffB); PG8_STAGE(PG8_SA(1, 0), a3, voffA);
            PG8_WAIT_V(8); PG8_WAIT_L(0); PG8_BAR; PG8_MMA(1, 0, At, B0); PG8_MMA(1, 1, At, B1); PG8_BAR; PG8_SCHED;
            } else {
            PG8_LDB(B0, 0, 0); PG8_SCHED; PG8_LDA(At, 0, 0); PG8_STAGE(PG8_SA(1, 1), a1 + hstep, voffA);
            PG8_WAIT_L(8); PG8_BAR; PG8_WAIT_L(0); PG8_MMA(0, 0, At, B0); PG8_BAR; PG8_SCHED;
            PG8_LDB(B1, 0, 1); PG8_STAGE(PG8_SB(0, 0), b2, voffB);
            PG8_BAR; PG8_WAIT_L(0); PG8_MMA(0, 1, At, B1); PG8_BAR;
            PG8_LDA(At, 0, 1); PG8_STAGE(PG8_SA(0, 0), a2, voffA);
            PG8_BAR; PG8_WAIT_L(0); PG8_MMA(1, 0, At, B0); PG8_BAR; PG8_SCHED;
            PG8_STAGE(PG8_SB(0, 1), b2 + hstep, voffB);
            PG8_WAIT_V(6); PG8_BAR; PG8_MMA(1, 1, At, B1); PG8_BAR;
            PG8_LDB(B0, 1, 0); PG8_SCHED; PG8_LDA(At, 1, 0); PG8_STAGE(PG8_SA(0, 1), a2 + hstep, voffA);
            PG8_WAIT_L(8); PG8_BAR; PG8_WAIT_L(0); PG8_MMA(0, 0, At, B0); PG8_BAR; PG8_SCHED;
            PG8_LDB(B1, 1, 1); PG8_STAGE(PG8_SB(1, 0), b3, voffB);
            PG8_BAR; PG8_WAIT_L(0); PG8_MMA(0, 1, At, B1); PG8_BAR;
            PG8_LDA(At, 1, 1); PG8_STAGE(PG8_SA(1, 0), a3, voffA);
            PG8_BAR; PG8_WAIT_L(0); PG8_MMA(1, 0, At, B0); PG8_BAR; PG8_SCHED;
            PG8_STAGE(PG8_SB(1, 1), b3 + hstep, voffB);
            PG8_WAIT_V(6); PG8_BAR; PG8_MMA(1, 1, At, B1); PG8_BAR;
            }
        }
        if constexpr (ALIGN_EPI) { if (wr == 0) PG8_BAR; }
        if constexpr (!Epi::AFTER_DRAIN) { E(acc, cur, wr, wc, fr, fq); S.done(cur); }
        if (!has_next) break;
#pragma unroll
        for (int a = 0; a < 2; ++a)
#pragma unroll
            for (int b = 0; b < 2; ++b)
#pragma unroll
                for (int m = 0; m < 4; ++m)
#pragma unroll
                    for (int n = 0; n < 2; ++n) acc[a][b][m][n] = (f32x4){0.f, 0.f, 0.f, 0.f};
        cur = nxt; cA = nA; cB = nB; ++ui;
        if constexpr (ALIGN_EPI) { if (wr == 1) PG8_BAR; }
    }
    PG8_WAIT_V(0);
    if constexpr (!ALIGN_EPI) { if (wr == 0) PG8_BAR; }
    PG8_BAR;
    if constexpr (Epi::AFTER_DRAIN) { E.fused(acc, cur, wr, wc, fr, fq, lds, wid, lane); S.done(cur); }
#undef PG8_SA
#undef PG8_SB
#undef PG8_STAGE
#undef PG8_LDA
#undef PG8_LDB
#undef PG8_MMA
#undef PG8_WAIT_V
#undef PG8_WAIT_L
#undef PG8_BAR
#undef PG8_SCHED
}
}

#define DI __device__ __forceinline__
#define LAS __attribute__((address_space(3)))
typedef unsigned short bf16_t;
typedef short bf16x8 __attribute__((ext_vector_type(8)));
typedef short s16x4 __attribute__((ext_vector_type(4)));
typedef float f32x4 __attribute__((ext_vector_type(4)));
typedef float f32x8 __attribute__((ext_vector_type(8)));
typedef float f32x16 __attribute__((ext_vector_type(16)));
typedef unsigned u32x4 __attribute__((ext_vector_type(4)));
typedef unsigned u32x2 __attribute__((ext_vector_type(2)));
typedef __bf16 bf8v __attribute__((ext_vector_type(8)));
typedef __bf16 bf4v __attribute__((ext_vector_type(4)));

constexpr int NB = 2, S = 8192, DM = 2048, MT = NB * S, NL = 4, HD = 64, NCOL = 8200, NPROJ = 8192;
constexpr float LOG2E = 1.4426950408889634f, LN2 = 0.6931471805599453f;
constexpr size_t MiB = 1u << 20;
constexpr size_t WS_CTL = 0, CTL_BYTES = 65536;
constexpr size_t WS_WIN = 1 * MiB;
constexpr size_t WS_WOUT = 129 * MiB;
constexpr size_t WS_XB = 161 * MiB;
constexpr size_t WS_Q = 225 * MiB;
constexpr size_t WS_K = 289 * MiB;
constexpr size_t WS_VT = 353 * MiB;
constexpr size_t WS_VTX = 417 * MiB;
constexpr size_t WS_G = 449 * MiB;
constexpr size_t WS_Y = 513 * MiB;
constexpr size_t WS_LOGF = 577 * MiB;
constexpr size_t WS_F = WS_LOGF + 512 * 1024;
constexpr size_t WS_KMP = 578 * MiB;
constexpr size_t WS_COS = 579 * MiB, WS_SIN = 580 * MiB;
constexpr size_t WS_WF = 581 * MiB;
constexpr size_t WS_END = 582 * MiB;
constexpr int LDS_BYTES = 147456;

struct Args { const float *x, *ng, *w_in, *qg, *kg, *fb, *w_out; float* out; unsigned char* ws; float inv_freq[32]; };

DI unsigned f2bf(float f) { unsigned u = __builtin_bit_cast(unsigned, f); return (u + 0x7fffu + ((u >> 16) & 1u)) >> 16; }
DI unsigned pk2(float lo, float hi) { return f2bf(lo) | (f2bf(hi) << 16); }
DI float bf2f(unsigned short b) { return __builtin_bit_cast(float, (unsigned)b << 16); }
DI bf16x8 pack8(f32x8 v) { bf8v b = __builtin_convertvector(v, bf8v); return __builtin_bit_cast(bf16x8, b); }
DI s16x4 pack4(f32x4 v) { bf4v b = __builtin_convertvector(v, bf4v); return __builtin_bit_cast(s16x4, b); }
template <int O> DI int shxi(int v) {
    if constexpr (O < 32) return __builtin_amdgcn_ds_swizzle(v, 0x1f | (O << 10));
    else { const auto r = __builtin_amdgcn_permlane32_swap((unsigned)v, (unsigned)v, false, false); return (int)((threadIdx.x & 32u) ? r[0] : r[1]); }
}
template <int O> DI float shx(float v) { return __builtin_bit_cast(float, shxi<O>(__builtin_bit_cast(int, v))); }
DI float wave_sum(float v) { v += shx<1>(v); v += shx<2>(v); v += shx<4>(v); v += shx<8>(v); v += shx<16>(v); v += shx<32>(v); return v; }
DI float wave_max(float v) { v = fmaxf(v, shx<1>(v)); v = fmaxf(v, shx<2>(v)); v = fmaxf(v, shx<4>(v)); v = fmaxf(v, shx<8>(v)); v = fmaxf(v, shx<16>(v)); v = fmaxf(v, shx<32>(v)); return v; }
DI f32x16 mfma32(bf16x8 a, bf16x8 b, f32x16 c) { return __builtin_amdgcn_mfma_f32_32x32x16_bf16(a, b, c, 0, 0, 0); }
DI float ex2(float x) { return __builtin_amdgcn_exp2f(x); }
DI float lg2(float x) { return __builtin_amdgcn_logf(x); }

struct EpiIn {
    static constexpr bool PERM = true, AFTER_DRAIN = false;
    bf16_t *Q, *K, *VT, *VTX, *G; float* KMP; const float *qg, *kg, *cosT, *sinT;
    __device__ __forceinline__ void operator()(const pg8::f32x4 (&acc)[2][2][4][2], const pg8::Unit& u, int wr, int wc, int fr, int fq) const {
        const int ms = (u.pn & 7) >> 1, mixer = ((ms & 1) << 1) | (ms >> 1);
        const int sec = u.pn >> 3, head = 4 * (u.pn & 1) + wc;
        const int b = u.pm >> 5, blk = u.pm & 31, sbase = blk * 256 + wr * 64 + fr, bh = b * 8 + head;
        if (sec <= 1) {
            const bool norm = mixer != 1, rope = (mixer == 0 || mixer == 2), km = (sec == 1 && mixer == 2);
            const float* gp = (sec == 0 ? qg : kg) + (mixer == 0 ? 0 : (mixer == 2 ? 1 : 2)) * 64;
            f32x4 gn[2][2], ks[2][2];
#pragma unroll
            for (int bj = 0; bj < 2; ++bj)
#pragma unroll
                for (int n = 0; n < 2; ++n) { gn[bj][n] = norm ? *(const f32x4*)(gp + 32 * bj + 8 * fq + 4 * n) : (f32x4){1.f, 1.f, 1.f, 1.f}; ks[bj][n] = (f32x4){0.f, 0.f, 0.f, 0.f}; }
            bf16_t* dst = (sec == 0 ? Q : K) + (size_t)(mixer * 16 + bh) * S * 64;
            const float osc = sec == 0 ? (mixer == 1 ? 0.125f : 0.125f * LOG2E) : 1.0f;
#pragma unroll
            for (int ai = 0; ai < 2; ++ai)
#pragma unroll
                for (int m = 0; m < 4; ++m) {
                    const int s = sbase + 128 * ai + 16 * m;
                    f32x4 v[2][2];
#pragma unroll
                    for (int bj = 0; bj < 2; ++bj)
#pragma unroll
                        for (int n = 0; n < 2; ++n) v[bj][n] = acc[ai][bj][m][n];
                    if (norm) {
                        float ss = 0.f;
#pragma unroll
                        for (int bj = 0; bj < 2; ++bj)
#pragma unroll
                            for (int n = 0; n < 2; ++n) { const f32x4 t = v[bj][n]; ss += (t[0] * t[0] + t[1] * t[1]) + (t[2] * t[2] + t[3] * t[3]); }
                        ss += shx<16>(ss); ss += shx<32>(ss);
                        const float rr = rsqrtf(ss * (1.0f / 64.0f) + 1e-6f);
#pragma unroll
                        for (int bj = 0; bj < 2; ++bj)
#pragma unroll
                            for (int n = 0; n < 2; ++n) v[bj][n] = v[bj][n] * rr * gn[bj][n];
                    }
                    if (rope) {
#pragma unroll
                        for (int n = 0; n < 2; ++n) {
                            const f32x4 c4 = *(const f32x4*)(cosT + (size_t)s * 32 + 8 * fq + 4 * n), s4 = *(const f32x4*)(sinT + (size_t)s * 32 + 8 * fq + 4 * n);
                            const f32x4 t1 = v[0][n], t2 = v[1][n];
                            v[0][n] = t1 * c4 - t2 * s4; v[1][n] = t2 * c4 + t1 * s4;
                        }
                    }
                    if (km) {
#pragma unroll
                        for (int bj = 0; bj < 2; ++bj)
#pragma unroll
                            for (int n = 0; n < 2; ++n) ks[bj][n] += v[bj][n];
                    }
#pragma unroll
                    for (int bj = 0; bj < 2; ++bj) {
                        const f32x4 a0 = v[bj][0] * osc, a1 = v[bj][1] * osc;
                        const bf16x8 w = pack8((f32x8){a0[0], a0[1], a0[2], a0[3], a1[0], a1[1], a1[2], a1[3]});
                        *(bf16x8*)(dst + (size_t)s * 64 + 32 * bj + 8 * fq) = w;
                    }
                }
            if (km) {
#pragma unroll
                for (int bj = 0; bj < 2; ++bj)
#pragma unroll
                    for (int n = 0; n < 2; ++n) {
                        f32x4 t = ks[bj][n];
#pragma unroll
                        for (int e = 0; e < 4; ++e) { float x = t[e]; x += shx<1>(x); x += shx<2>(x); x += shx<4>(x); x += shx<8>(x); t[e] = x; }
                        if (fr == 0) *(f32x4*)(KMP + ((size_t)(bh * 32 + blk) * 2 + wr) * 64 + 32 * bj + 8 * fq + 4 * n) = t;
                    }
            }
        } else if (sec == 2) {
            bf16_t* vt = VT + (size_t)(mixer * 16 + bh) * 64 * S;
            bf16_t* vx0 = VTX + (size_t)bh * 64 * S;
            bf16_t* vx1 = VTX + (size_t)(16 + bh) * 64 * S;
#pragma unroll
            for (int ai = 0; ai < 2; ++ai)
#pragma unroll
                for (int m = 0; m < 4; ++m) {
                    const int s = sbase + 128 * ai + 16 * m;
                    const int s4 = (s & 3) * (S / 4) + (s >> 2), s16 = (s & 15) * (S / 16) + (s >> 4);
#pragma unroll
                    for (int bj = 0; bj < 2; ++bj)
#pragma unroll
                        for (int n = 0; n < 2; ++n)
#pragma unroll
                            for (int e = 0; e < 4; ++e) {
                                const int d = 32 * bj + 8 * fq + 4 * n + e;
                                const bf16_t w = (bf16_t)f2bf(acc[ai][bj][m][n][e]);
                                vt[(size_t)d * S + s] = w;
                                if (mixer == 0) { vx0[(size_t)d * S + s4] = w; vx1[(size_t)d * S + s16] = w; }
                            }
                }
        } else {
            const int col = 512 * mixer + 256 * (u.pn & 1) + 64 * wc + 8 * fq;
#pragma unroll
            for (int ai = 0; ai < 2; ++ai)
#pragma unroll
                for (int m = 0; m < 4; ++m) {
                    const size_t row = (size_t)u.pm * 256 + 128 * ai + 64 * wr + 16 * m + fr;
#pragma unroll
                    for (int bj = 0; bj < 2; ++bj) {
                        f32x8 t;
#pragma unroll
                        for (int n = 0; n < 2; ++n)
#pragma unroll
                            for (int e = 0; e < 4; ++e) { const float z = acc[ai][bj][m][n][e]; t[4 * n + e] = z / (1.0f + __expf(-z)); }
                        *(bf16x8*)(G + row * DM + col + 32 * bj) = pack8(t);
                    }
                }
        }
    }
};
struct EpiOut {
    static constexpr bool PERM = false, AFTER_DRAIN = false;
    const float* src; float* out;
    __device__ __forceinline__ void operator()(const pg8::f32x4 (&acc)[2][2][4][2], const pg8::Unit& u, int wr, int wc, int fr, int fq) const {
#pragma unroll
        for (int ai = 0; ai < 2; ++ai)
#pragma unroll
            for (int m = 0; m < 4; ++m) {
                const size_t row = (size_t)u.pm * 256 + 128 * ai + 64 * wr + 16 * m + fr;
#pragma unroll
                for (int bj = 0; bj < 2; ++bj)
#pragma unroll
                    for (int n = 0; n < 2; ++n) {
                        const size_t off = row * DM + u.pn * 256 + 128 * bj + 32 * wc + 16 * n + 4 * fq;
                        const f32x4 r = *(const f32x4*)(src + off);
                        *(f32x4*)(out + off) = r + acc[ai][bj][m][n];
                    }
                asm volatile("" ::: "memory");
            }
    }
};

DI void transpose_item(const float* W, int ldw, const float* gain, bf16_t* WT, int K, int k0, int n0, int nd, LAS float* scr, int lane) {
    f32x4 tw[8]; float gg[8];
#pragma unroll
    for (int i = 0; i < 8; ++i) { const int kk = 8 * i + (lane >> 3); tw[i] = *(const f32x4*)(W + (size_t)(k0 + kk) * ldw + n0 + 4 * (lane & 7)); gg[i] = gain ? gain[k0 + kk] : 1.0f; }
#pragma unroll
    for (int i = 0; i < 8; ++i) { const int kk = 8 * i + (lane >> 3); LAS float* d = scr + kk * 33 + 4 * (lane & 7);
        d[0] = tw[i][0] * gg[i]; d[1] = tw[i][1] * gg[i]; d[2] = tw[i][2] * gg[i]; d[3] = tw[i][3] * gg[i]; }
    asm volatile("s_waitcnt lgkmcnt(0)" ::: "memory");
    const int c = lane & 7;
#pragma unroll
    for (int j = 0; j < 4; ++j) { const int n = (lane >> 3) + 8 * j; const LAS float* s = scr + (8 * c) * 33 + n;
        u32x4 o; o.x = pk2(s[0 * 33], s[1 * 33]); o.y = pk2(s[2 * 33], s[3 * 33]); o.z = pk2(s[4 * 33], s[5 * 33]); o.w = pk2(s[6 * 33], s[7 * 33]);
        *(u32x4*)(WT + (size_t)(nd + n) * K + k0 + 8 * c) = o; }
    asm volatile("s_waitcnt lgkmcnt(0)" ::: "memory");
}

DI void norm_row(const float* xrow, const LAS f32x4* wfl, const float* fbias, bf16_t* orow, float* logf_b  , int s, int lane) {
    asm volatile("" ::: "memory");
    f32x4 v[8]; float ss = 0.f; float fl[8];
#pragma unroll
    for (int h = 0; h < 8; ++h) fl[h] = 0.f;
#pragma unroll
    for (int j = 0; j < 8; ++j) { v[j] = ((const f32x4*)xrow)[lane + 64 * j]; ss += (v[j][0] * v[j][0] + v[j][1] * v[j][1]) + (v[j][2] * v[j][2] + v[j][3] * v[j][3]); }
#pragma unroll
    for (int j = 0; j < 8; ++j) {
#pragma unroll
        for (int e = 0; e < 4; ++e) {
            const float xg = v[j][e];
            const f32x4 w0 = wfl[((j * 4 + e) * 2 + 0) * 64 + lane], w1 = wfl[((j * 4 + e) * 2 + 1) * 64 + lane];
            fl[0] += xg * w0[0]; fl[1] += xg * w0[1]; fl[2] += xg * w0[2]; fl[3] += xg * w0[3];
            fl[4] += xg * w1[0]; fl[5] += xg * w1[1]; fl[6] += xg * w1[2]; fl[7] += xg * w1[3];
        }
    }
    ss = wave_sum(ss);
#pragma unroll
    for (int h = 0; h < 8; ++h) fl[h] = wave_sum(fl[h]);
    const float rstd = rsqrtf(ss * (1.0f / DM) + 1e-6f);
    unsigned long long* o8 = (unsigned long long*)orow + lane;
#pragma unroll
    for (int j = 0; j < 8; ++j) o8[64 * j] = (unsigned long long)pk2(v[j][0] * rstd, v[j][1] * rstd) | ((unsigned long long)pk2(v[j][2] * rstd, v[j][3] * rstd) << 32);
    float mine = fl[0];
#pragma unroll
    for (int h = 1; h < 8; ++h) mine = (lane == h) ? fl[h] : mine;
    if (lane < 8) {
        const float z = mine * rstd + fbias[lane];
        const float lf = fminf(z, 0.f) - log1pf(expf(-fabsf(z)));
        logf_b[(size_t)lane * S + s] = lf;
    }
}

DI int crow(int i, int h) { return (i & 3) + 8 * (i >> 2) + 4 * h; }
DI int kperm(int r) { return (r & ~12) | ((r & 4) << 1) | ((r & 8) >> 1); }
DI int kidx(int i, int h) { return 16 * (i >> 3) + 8 * h + (i & 7); }
DI void load_q(bf16x8 (&qf)[4], const bf16_t* qrow) {
#pragma unroll
    for (int sp = 0; sp < 4; ++sp) qf[sp] = *(const bf16x8*)(qrow + 16 * sp);
}
DI void load_v(bf16x8 (&vf)[2][2], const bf16_t* vb  ) {
#pragma unroll
    for (int dd = 0; dd < 2; ++dd)
#pragma unroll
        for (int s = 0; s < 2; ++s) vf[dd][s] = *(const bf16x8*)(vb + (size_t)dd * 32 * S + 16 * s);
}
DI f32x16 qk_tile(const bf16x8 (&kf)[4], const bf16x8 (&qf)[4]) {
    f32x16 x;
#pragma unroll
    for (int i = 0; i < 16; ++i) x[i] = 0.f;
#pragma unroll
    for (int sp = 0; sp < 4; ++sp) x = mfma32(kf[sp], qf[sp], x);
    return x;
}
DI void pv_tile(f32x16& o0, f32x16& o1, const bf16x8 (&vf)[2][2], const float (&p)[16]) {
    const bf16x8 p0 = pack8((f32x8){p[0], p[1], p[2], p[3], p[4], p[5], p[6], p[7]});
    const bf16x8 p1 = pack8((f32x8){p[8], p[9], p[10], p[11], p[12], p[13], p[14], p[15]});
    o0 = mfma32(vf[0][0], p0, o0); o0 = mfma32(vf[0][1], p1, o0);
    o1 = mfma32(vf[1][0], p0, o1); o1 = mfma32(vf[1][1], p1, o1);
}
DI void store_y(const f32x16& o0, const f32x16& o1, float inv, const bf16_t* G, bf16_t* Y, size_t row, int col0, int h) {
#pragma unroll
    for (int dd = 0; dd < 2; ++dd)
#pragma unroll
        for (int g = 0; g < 4; ++g) {
            const size_t off = row * DM + col0 + 32 * dd + 8 * g + 4 * h;
            const s16x4 gt = *(const s16x4*)(G + off);
            f32x4 t;
#pragma unroll
            for (int e = 0; e < 4; ++e) t[e] = (dd == 0 ? o0[4 * g + e] : o1[4 * g + e]) * inv * bf2f((unsigned short)gt[e]);
            *(s16x4*)(Y + off) = pack4(t);
        }
}

template <int MODE>
DI void attn_item(const bf16_t* Qm, const bf16_t* Km, const bf16_t* Vtm, const float* Fb, const float* KMPb, const bf16_t* G, bf16_t* Y, int bh, int qt, int mixer, float Mb, int lane) {
    asm volatile("" : "+v"(lane));
    const int r = lane & 31, h = lane >> 5;
    const int q0 = qt * 32, t = q0 + r;
    bf16x8 qf[4];
    load_q(qf, Qm + ((size_t)bh * S + t) * 64 + 8 * h);
    const bf16_t* kb = Km + ((size_t)bh * S + kperm(r)) * 64 + 8 * h;
    const bf16_t* vb = Vtm + ((size_t)bh * 64 + r) * S + 8 * h;
    const int qblk = qt >> 3;
    unsigned sel = 0u, vis = 0xffffffffu;
    float ft = 0.f, Ft0 = 0.f;
    if (MODE == 3) { ft = Fb[t]; Ft0 = Fb[q0]; }
    if (MODE == 2) {
        if (qblk > 0) {
            f32x16 gx;
#pragma unroll
            for (int i = 0; i < 16; ++i) gx[i] = 0.f;
#pragma unroll
            for (int sp = 0; sp < 4; ++sp) {
                const float* kp = KMPb + (size_t)(r * 2) * 64 + 16 * sp + 8 * h;
                const f32x4 a0 = *(const f32x4*)kp, a1 = *(const f32x4*)(kp + 4), b0 = *(const f32x4*)(kp + 64), b1 = *(const f32x4*)(kp + 68);
                f32x8 km, hi_f;
#pragma unroll
                for (int e = 0; e < 4; ++e) { km[e] = (a0[e] + b0[e]) * (1.0f / 256.0f); km[4 + e] = (a1[e] + b1[e]) * (1.0f / 256.0f); }
                const bf16x8 hi = pack8(km);
#pragma unroll
                for (int e = 0; e < 8; ++e) hi_f[e] = km[e] - bf2f((unsigned short)hi[e]);
                const bf16x8 lo = pack8(hi_f);
                gx = mfma32(hi, qf[sp], gx); gx = mfma32(lo, qf[sp], gx);
            }
            const float NEGI = -__builtin_inff();
#pragma unroll
            for (int i = 0; i < 16; ++i) if (crow(i, h) >= qblk) gx[i] = NEGI;
#pragma unroll
            for (int it = 0; it < 3; ++it) {
                float bv = NEGI; int bn = 64;
#pragma unroll
                for (int i = 0; i < 16; ++i) if (gx[i] > bv) { bv = gx[i]; bn = crow(i, h); }
                const float pv = shx<32>(bv); const int pn = shxi<32>(bn);
                if (pv > bv || (pv == bv && pn < bn)) { bv = pv; bn = pn; }
                if (bv > NEGI) sel |= 1u << bn;
#pragma unroll
                for (int i = 0; i < 16; ++i) if (crow(i, h) == bn) gx[i] = NEGI;
            }
        }
        vis = sel;
        vis |= (unsigned)shxi<1>((int)vis); vis |= (unsigned)shxi<2>((int)vis); vis |= (unsigned)shxi<4>((int)vis); vis |= (unsigned)shxi<8>((int)vis); vis |= (unsigned)shxi<16>((int)vis); vis |= (unsigned)shxi<32>((int)vis);
        vis |= 1u << qblk;
    }
    f32x16 o0, o1;
#pragma unroll
    for (int i = 0; i < 16; ++i) { o0[i] = 0.f; o1[i] = 0.f; }
    float l = 0.f, R = 0.f;
    const float mb2 = -Mb * LOG2E;

    int tau = qt;
    bf16x8 kfA[4], vfA[2][2]; f32x4 fsA[4];
    load_q(kfA, kb + (size_t)tau * 32 * 64);
    load_v(vfA, vb + tau * 32);
    if (MODE == 3) {
#pragma unroll
        for (int g = 0; g < 4; ++g) fsA[g] = *(const f32x4*)(Fb + tau * 32 + 16 * (g >> 1) + 8 * h + 4 * (g & 1));
    }
    while (tau >= 0) {
        int nxt = tau - 1;
        if (MODE == 2) { while (nxt >= 0 && !((vis >> (nxt >> 3)) & 1u)) nxt = (nxt >> 3) * 8 - 1; }
        if (MODE == 3) { if (nxt >= 0) { const float fk = Fb[nxt * 32 + 31]; if ((Ft0 - fk) + 2.0f * Mb < -104.0f) nxt = -1; } }
        nxt = __builtin_amdgcn_readfirstlane(nxt);
        bf16x8 kfB[4], vfB[2][2]; f32x4 fsB[4];
#pragma unroll
        for (int sp = 0; sp < 4; ++sp) kfB[sp] = kfA[sp];
#pragma unroll
        for (int dd = 0; dd < 2; ++dd) { vfB[dd][0] = vfA[dd][0]; vfB[dd][1] = vfA[dd][1]; }
#pragma unroll
        for (int g = 0; g < 4; ++g) fsB[g] = fsA[g];
        if (nxt >= 0) {
            load_q(kfB, kb + (size_t)nxt * 32 * 64);
            load_v(vfB, vb + nxt * 32);
            if (MODE == 3) {
#pragma unroll
                for (int g = 0; g < 4; ++g) fsB[g] = *(const f32x4*)(Fb + nxt * 32 + 16 * (g >> 1) + 8 * h + 4 * (g & 1));
            }
        }
        const f32x16 x = qk_tile(kfA, qf);
        const bool diag = (tau == qt);
        float p[16];
        if (MODE == 1) {
            float sp_[16];
#pragma unroll
            for (int i = 0; i < 16; ++i) {
                const float z = x[i];
                sp_[i] = fmaxf(z, 0.f) + LN2 * lg2(1.0f + ex2(-fabsf(z) * LOG2E));
            }
            if (diag) {
#pragma unroll
                for (int i = 0; i < 16; ++i) if (!(kidx(i, h) < r)) sp_[i] = 0.f;
            }
            float sfx[16], T[2], bT[2];
#pragma unroll
            for (int o = 0; o < 2; ++o) {
                sfx[8 * o + 7] = sp_[8 * o + 7];
#pragma unroll
                for (int e = 6; e >= 0; --e) sfx[8 * o + e] = sp_[8 * o + e] + sfx[8 * o + e + 1];
                T[o] = sfx[8 * o];
                bT[o] = shx<32>(T[o]);
            }
            float off[2];
            off[1] = R + (h == 0 ? bT[1] : 0.f);
            off[0] = R + (T[1] + bT[1]) + (h == 0 ? bT[0] : 0.f);
            R = R + (T[1] + bT[1]) + (T[0] + bT[0]);
#pragma unroll
            for (int i = 0; i < 16; ++i) {
                const float c = off[i >> 3] + sfx[i];
                p[i] = ex2((x[i] - c) * LOG2E);
            }
            if (diag) {
#pragma unroll
                for (int i = 0; i < 16; ++i) if (!(kidx(i, h) < r)) p[i] = 0.f;
            }
        } else if (MODE == 2) {
            const int nb = tau >> 3;
            const bool own = (nb == qblk);
            const bool lane_ok = own || ((sel >> nb) & 1u);
#pragma unroll
            for (int i = 0; i < 16; ++i) {
                float v = ex2(fmaf(x[i], LOG2E, mb2));
                if (!lane_ok || (diag && kidx(i, h) > r)) v = 0.f;
                p[i] = v; l += v;
            }
        } else {
#pragma unroll
            for (int i = 0; i < 16; ++i) {
                const float dF = ft - fsA[i >> 2][i & 3];
                float v = ex2(fmaf(x[i], LOG2E, (dF - Mb) * LOG2E));
                if (diag && kidx(i, h) > r) v = 0.f;
                p[i] = v; l += v;
            }
        }
        pv_tile(o0, o1, vfA, p);
        if (MODE == 1) { if (__ballot(R < 104.0f) == 0ull) nxt = -1; }
#pragma unroll
        for (int sp = 0; sp < 4; ++sp) kfA[sp] = kfB[sp];
#pragma unroll
        for (int dd = 0; dd < 2; ++dd) { vfA[dd][0] = vfB[dd][0]; vfA[dd][1] = vfB[dd][1]; }
#pragma unroll
        for (int g = 0; g < 4; ++g) fsA[g] = fsB[g];
        tau = nxt;
    }
    float inv = 1.0f;
    if (MODE != 1) { l += shx<32>(l); inv = 1.0f / l; }
    store_y(o0, o1, inv, G, Y, (size_t)(bh >> 3) * S + t, mixer * 512 + (bh & 7) * 64, h);
}

constexpr int AW_K = 0, AW_V = 9216, AW_F = 9216 + 9216, AW_BUF = 9216 + 9216 + 256;
DI unsigned moba_select(const float* KMPb, const bf16x8 (&qf)[4], int qblk, int r, int h) {
    unsigned sel = 0u;
    if (qblk > 0) {
        f32x16 gx;
#pragma unroll
        for (int i = 0; i < 16; ++i) gx[i] = 0.f;
#pragma unroll
        for (int sp = 0; sp < 4; ++sp) {
            const float* kp = KMPb + (size_t)(r * 2) * 64 + 16 * sp + 8 * h;
            const f32x4 a0 = *(const f32x4*)kp, a1 = *(const f32x4*)(kp + 4), b0 = *(const f32x4*)(kp + 64), b1 = *(const f32x4*)(kp + 68);
            f32x8 km, hi_f;
#pragma unroll
            for (int e = 0; e < 4; ++e) { km[e] = (a0[e] + b0[e]) * (1.0f / 256.0f); km[4 + e] = (a1[e] + b1[e]) * (1.0f / 256.0f); }
            const bf16x8 hi = pack8(km);
#pragma unroll
            for (int e = 0; e < 8; ++e) hi_f[e] = km[e] - bf2f((unsigned short)hi[e]);
            const bf16x8 lo = pack8(hi_f);
            gx = mfma32(hi, qf[sp], gx); gx = mfma32(lo, qf[sp], gx);
        }
        const float NEGI = -__builtin_inff();
#pragma unroll
        for (int i = 0; i < 16; ++i) if (crow(i, h) >= qblk) gx[i] = NEGI;
#pragma unroll
        for (int it = 0; it < 3; ++it) {
            float bv = NEGI; int bn = 64;
#pragma unroll
            for (int i = 0; i < 16; ++i) if (gx[i] > bv) { bv = gx[i]; bn = crow(i, h); }
            const float pv = shx<32>(bv); const int pn = shxi<32>(bn);
            if (pv > bv || (pv == bv && pn < bn)) { bv = pv; bn = pn; }
            if (bv > NEGI) sel |= 1u << bn;
#pragma unroll
            for (int i = 0; i < 16; ++i) if (crow(i, h) == bn) gx[i] = NEGI;
        }
    }
    return sel;
}
DI unsigned wave_or(unsigned v) { v |= (unsigned)shxi<1>((int)v); v |= (unsigned)shxi<2>((int)v); v |= (unsigned)shxi<4>((int)v); v |= (unsigned)shxi<8>((int)v); v |= (unsigned)shxi<16>((int)v); v |= (unsigned)shxi<32>((int)v); return v; }

template <int MODE>
DI void sub_tile(const bf16x8 (&kf)[4], const bf16x8 (&vf)[2][2], const bf16x8 (&qf)[4], f32x16& o0, f32x16& o1, float& l, bool diag, float offs, float fm, const LAS float* fsp, int r, int h) {
    f32x16 x;
    float p[16];
    if (MODE == 2) {
#pragma unroll
        for (int i = 0; i < 16; ++i) x[i] = offs;
#pragma unroll
        for (int sp = 0; sp < 4; ++sp) x = mfma32(kf[sp], qf[sp], x);
#pragma unroll
        for (int i = 0; i < 16; ++i) p[i] = ex2(x[i]);
    } else {
        x = qk_tile(kf, qf);
#pragma unroll
        for (int g = 0; g < 4; ++g) {
            const f32x4 fs = *(const LAS f32x4*)(fsp + 16 * (g >> 1) + 8 * h + 4 * (g & 1));
#pragma unroll
            for (int e = 0; e < 4; ++e) p[4 * g + e] = ex2(x[4 * g + e] + (fm - fs[e]));
        }
    }
    if (diag) {
#pragma unroll
        for (int i = 0; i < 16; ++i) if (kidx(i, h) > r) p[i] = 0.f;
    }
#pragma unroll
    for (int i = 0; i < 16; ++i) l += p[i];
    pv_tile(o0, o1, vf, p);
}

template <int MODE>
DI void attn_wg2_item(const bf16_t* Qm, const bf16_t* Km, const bf16_t* Vtm, const float* Fb, const float* KMPb, const bf16_t* G, bf16_t* Y, int bh, int qb2, int halfq, int mixer, float Mb, LAS unsigned char* lds, int tid, int wave, int lane) {
    asm volatile("" : "+v"(tid), "+v"(lane));
    const int r = lane & 31, h = lane >> 5;
    const int qtA = halfq ? qb2 * 8 + wave : qb2 * 16 + wave, qtB = halfq ? -1 : qb2 * 16 + 15 - wave, tA = qtA * 32 + r, tB = halfq ? tA : qtB * 32 + r;
    bf16x8 qfA[4], qfB[4];
    load_q(qfA, Qm + ((size_t)bh * S + tA) * 64 + 8 * h);
    load_q(qfB, Qm + ((size_t)bh * S + tB) * 64 + 8 * h);
    const int qblkA = qtA >> 3, qblkB = halfq ? 0 : (qtB >> 3);
    unsigned selA = 0u, selB = 0u, visA = 0xffffffffu, visB = 0xffffffffu;
    float fmA = 0.f, fmB = 0.f, Ft0 = 0.f;
    if (MODE == 3) { fmA = (Fb[tA] - Mb) * LOG2E; fmB = (Fb[tB] - Mb) * LOG2E; Ft0 = Fb[halfq ? qb2 * 256 : qb2 * 512]; }
    if (MODE == 2) {
        selA = moba_select(KMPb, qfA, qblkA, r, h); selB = halfq ? 0u : moba_select(KMPb, qfB, qblkB, r, h);
        visA = wave_or(selA) | (1u << qblkA); visB = wave_or(selB) | (1u << qblkB);
    }
    f32x16 oA0, oA1, oB0, oB1;
#pragma unroll
    for (int i = 0; i < 16; ++i) { oA0[i] = 0.f; oA1[i] = 0.f; oB0[i] = 0.f; oB1[i] = 0.f; }
    float lA = 0.f, lB = 0.f;
    const float mb2 = -Mb * LOG2E, NEGI = -__builtin_inff();
    const int srow = tid >> 3, sch = tid & 7;
    const bf16_t* kg = Km + ((size_t)bh * S + srow) * 64 + sch * 8;
    const bf16_t* vg = Vtm + ((size_t)bh * 64 + srow) * S + sch * 8;
    const unsigned kws = AW_K + srow * 144 + sch * 16, vws = AW_V + srow * 144 + sch * 16;
    const unsigned kra = AW_K + kperm(r) * 144 + 16 * h, vra = AW_V + r * 144 + 16 * h;
    int cur = halfq ? qb2 * 4 + 3 : qb2 * 8 + 7, buf = 0;
    {
        const bf16x8 kreg = *(const bf16x8*)(kg + (size_t)cur * 4096);
        const u32x4 vreg = *(const u32x4*)(vg + cur * 64);
        *(LAS bf16x8*)(lds + kws) = kreg;
        *(LAS u32x4*)(lds + vws) = vreg;
        if (MODE == 3 && tid < 16) *(LAS f32x4*)(lds + AW_F + tid * 16) = *(const f32x4*)(Fb + cur * 64 + tid * 4) * LOG2E;
    }
    __syncthreads();
    while (cur >= 0) {
        int nxt = cur - 1;
        if (MODE == 3) { if (nxt >= 0) { const float fk = Fb[nxt * 64 + 63]; if ((Ft0 - fk) + 2.0f * Mb < -104.0f) nxt = -1; } }
        nxt = __builtin_amdgcn_readfirstlane(nxt);
        bf16x8 kreg; u32x4 vreg; f32x4 freg;
#pragma unroll
        for (int e = 0; e < 8; ++e) kreg[e] = 0;
        vreg = (u32x4){0u, 0u, 0u, 0u}; freg = (f32x4){0.f, 0.f, 0.f, 0.f};
        if (nxt >= 0) {
            kreg = *(const bf16x8*)(kg + (size_t)nxt * 4096);
            vreg = *(const u32x4*)(vg + nxt * 64);
            if (MODE == 3 && tid < 16) freg = *(const f32x4*)(Fb + nxt * 64 + tid * 4);
        }
        LAS unsigned char* lb = lds + buf * AW_BUF;
#pragma unroll
        for (int kk = 1; kk >= 0; --kk) {
            const int tau = cur * 2 + kk, nb = tau >> 3;
            bool actA = tau <= qtA, actB = tau <= qtB;
            if (MODE == 2) { actA = actA && ((visA >> nb) & 1u); actB = actB && ((visB >> nb) & 1u); }
            if (actA || actB) {
                bf16x8 kf[4], vf[2][2];
#pragma unroll
                for (int sp = 0; sp < 4; ++sp) kf[sp] = *(LAS bf16x8*)(lb + kra + kk * 32 * 144 + sp * 32);
#pragma unroll
                for (int dd = 0; dd < 2; ++dd)
#pragma unroll
                    for (int s = 0; s < 2; ++s) vf[dd][s] = *(LAS bf16x8*)(lb + vra + dd * 32 * 144 + kk * 64 + s * 32);
                float offA = mb2, offB = mb2;
                if (MODE == 2) { offA = ((nb == qblkA) || ((selA >> nb) & 1u)) ? mb2 : NEGI; offB = ((nb == qblkB) || ((selB >> nb) & 1u)) ? mb2 : NEGI; }
                const LAS float* fsp = (const LAS float*)(lb + AW_F) + kk * 32;
                if (actA) sub_tile<MODE>(kf, vf, qfA, oA0, oA1, lA, tau == qtA, offA, fmA, fsp, r, h);
                if (actB) sub_tile<MODE>(kf, vf, qfB, oB0, oB1, lB, tau == qtB, offB, fmB, fsp, r, h);
            }
        }
        if (nxt >= 0) {
            LAS unsigned char* nb_ = lds + (buf ^ 1) * AW_BUF;
            *(LAS bf16x8*)(nb_ + kws) = kreg;
            *(LAS u32x4*)(nb_ + vws) = vreg;
            if (MODE == 3 && tid < 16) *(LAS f32x4*)(nb_ + AW_F + tid * 16) = freg * LOG2E;
        }
        __syncthreads();
        buf ^= 1; cur = nxt;
    }
    lA += shx<32>(lA); lB += shx<32>(lB);
    store_y(oA0, oA1, 1.0f / lA, G, Y, (size_t)(bh >> 3) * S + tA, mixer * 512 + (bh & 7) * 64, h);
    if (!halfq) store_y(oB0, oB1, 1.0f / lB, G, Y, (size_t)(bh >> 3) * S + tB, mixer * 512 + (bh & 7) * 64, h);
}

DI void sub_tile_sb(const bf16x8 (&kf)[4], const bf16x8 (&vf)[2][2], const bf16x8 (&qf)[4], f32x16& o0, f32x16& o1, float& R, bool diag, int r, int h) {
    const f32x16 x = qk_tile(kf, qf);
    float sp_[16], p[16];
#pragma unroll
    for (int e = 0; e < 16; ++e) { const float z = x[e]; sp_[e] = fmaxf(z, 0.f) + LN2 * lg2(1.0f + ex2(-fabsf(z) * LOG2E)); }
    if (diag) {
#pragma unroll
        for (int e = 0; e < 16; ++e) if (!(kidx(e, h) < r)) sp_[e] = 0.f;
    }
    float sfx[16], T[2], bT[2];
#pragma unroll
    for (int o = 0; o < 2; ++o) {
        sfx[8 * o + 7] = sp_[8 * o + 7];
#pragma unroll
        for (int e = 6; e >= 0; --e) sfx[8 * o + e] = sp_[8 * o + e] + sfx[8 * o + e + 1];
        T[o] = sfx[8 * o];
        bT[o] = shx<32>(T[o]);
    }
    float off[2];
    off[1] = R + (h == 0 ? bT[1] : 0.f);
    off[0] = R + (T[1] + bT[1]) + (h == 0 ? bT[0] : 0.f);
    R = R + (T[1] + bT[1]) + (T[0] + bT[0]);
#pragma unroll
    for (int e = 0; e < 16; ++e) p[e] = ex2((x[e] - (off[e >> 3] + sfx[e])) * LOG2E);
    if (diag) {
#pragma unroll
        for (int e = 0; e < 16; ++e) if (!(kidx(e, h) < r)) p[e] = 0.f;
    }
    pv_tile(o0, o1, vf, p);
}
DI void attn_wgB_item(const bf16_t* Qm, const bf16_t* Km, const bf16_t* Vtm, const bf16_t* G, bf16_t* Y, int bh, int qb2, int halfq, LAS unsigned char* lds, int tid, int wave, int lane) {
    asm volatile("" : "+v"(tid), "+v"(lane));
    const int r = lane & 31, h = lane >> 5;
    const int qtA = halfq ? qb2 * 8 + wave : qb2 * 16 + wave, qtB = halfq ? -1 : qb2 * 16 + 15 - wave, tA = qtA * 32 + r, tB = halfq ? tA : qtB * 32 + r;
    bf16x8 qfA[4], qfB[4];
    load_q(qfA, Qm + ((size_t)bh * S + tA) * 64 + 8 * h);
    load_q(qfB, Qm + ((size_t)bh * S + tB) * 64 + 8 * h);
    f32x16 oA0, oA1, oB0, oB1;
#pragma unroll
    for (int i = 0; i < 16; ++i) { oA0[i] = 0.f; oA1[i] = 0.f; oB0[i] = 0.f; oB1[i] = 0.f; }
    float RA = 0.f, RB = 0.f;
    bool doneA = false, doneB = (halfq != 0);
    const int srow = tid >> 3, sch = tid & 7;
    const bf16_t* kg = Km + ((size_t)bh * S + srow) * 64 + sch * 8;
    const bf16_t* vg = Vtm + ((size_t)bh * 64 + srow) * S + sch * 8;
    const unsigned kws = AW_K + srow * 144 + sch * 16, vws = AW_V + srow * 144 + sch * 16;
    const unsigned kra = AW_K + kperm(r) * 144 + 16 * h, vra = AW_V + r * 144 + 16 * h;
    LAS int* fl = (LAS int*)(lds + 2 * AW_BUF);
    int cur = halfq ? qb2 * 4 + 3 : qb2 * 8 + 7, buf = 0, it = 0;
    {
        const bf16x8 kreg = *(const bf16x8*)(kg + (size_t)cur * 4096);
        const u32x4 vreg = *(const u32x4*)(vg + cur * 64);
        *(LAS bf16x8*)(lds + kws) = kreg;
        *(LAS u32x4*)(lds + vws) = vreg;
    }
    __syncthreads();
    while (cur >= 0) {
        int nxt = cur - 1;
        bf16x8 kreg; u32x4 vreg;
#pragma unroll
        for (int e = 0; e < 8; ++e) kreg[e] = 0;
        vreg = (u32x4){0u, 0u, 0u, 0u};
        if (nxt >= 0) {
            kreg = *(const bf16x8*)(kg + (size_t)nxt * 4096);
            vreg = *(const u32x4*)(vg + nxt * 64);
        }
        LAS unsigned char* lb = lds + buf * AW_BUF;
#pragma unroll
        for (int kk = 1; kk >= 0; --kk) {
            const int tau = cur * 2 + kk;
            const bool actA = (tau <= qtA) && !doneA, actB = (tau <= qtB) && !doneB;
            if (actA || actB) {
                bf16x8 kf[4], vf[2][2];
#pragma unroll
                for (int sp = 0; sp < 4; ++sp) kf[sp] = *(LAS bf16x8*)(lb + kra + kk * 32 * 144 + sp * 32);
#pragma unroll
                for (int dd = 0; dd < 2; ++dd)
#pragma unroll
                    for (int s = 0; s < 2; ++s) vf[dd][s] = *(LAS bf16x8*)(lb + vra + dd * 32 * 144 + kk * 64 + s * 32);
                if (actA) { sub_tile_sb(kf, vf, qfA, oA0, oA1, RA, tau == qtA, r, h); if (__ballot(RA < 104.0f) == 0ull) doneA = true; }
                if (actB) { sub_tile_sb(kf, vf, qfB, oB0, oB1, RB, tau == qtB, r, h); if (__ballot(RB < 104.0f) == 0ull) doneB = true; }
            }
        }
        if (nxt >= 0) {
            LAS unsigned char* nb_ = lds + (buf ^ 1) * AW_BUF;
            *(LAS bf16x8*)(nb_ + kws) = kreg;
            *(LAS u32x4*)(nb_ + vws) = vreg;
        }
        if (lane == 0) fl[(it & 1) * 8 + wave] = (doneA && doneB) ? 1 : 0;
        __syncthreads();
        int all = 1;
#pragma unroll
        for (int w = 0; w < 8; ++w) all &= fl[(it & 1) * 8 + w];
        if (__builtin_amdgcn_readfirstlane(all)) nxt = -1;
        buf ^= 1; cur = nxt; ++it;
    }
    store_y(oA0, oA1, 1.0f, G, Y, (size_t)(bh >> 3) * S + tA, 1 * 512 + (bh & 7) * 64, h);
    if (!halfq) store_y(oB0, oB1, 1.0f, G, Y, (size_t)(bh >> 3) * S + tB, 1 * 512 + (bh & 7) * 64, h);
}

DI void attn_A_item(const bf16_t* Q0, const bf16_t* K0, const bf16_t* VT0, const bf16_t* VTXp, const bf16_t* G, bf16_t* Y, int bh, int blk, float Mb, LAS float* Oacc, LAS float* lacc, int tid, int wave, int lane) {
    asm volatile("" : "+v"(tid), "+v"(lane));
    const int r = lane & 31, h = lane >> 5, t0 = blk * 512;
    {
        LAS f32x4* row = (LAS f32x4*)(Oacc + tid * 68);
#pragma unroll
        for (int i = 0; i < 17; ++i) row[i] = (f32x4){0.f, 0.f, 0.f, 0.f};
        lacc[tid] = 0.f;
    }
    __syncthreads();
    const float mb2 = -Mb * LOG2E;
#pragma unroll 1
    for (int seg = 0; seg < 3; ++seg) {
        const int sh = 2 * seg, L = S >> sh;
        const bf16_t* Vs = (seg == 0) ? (VT0 + (size_t)bh * 64 * S) : (VTXp + (size_t)((seg - 1) * 16 + bh) * 64 * S);
#pragma unroll
        for (int jq = 0; jq < 2; ++jq) {
            const int j = 2 * wave + jq, tpr = 16 >> sh, res = j / tpr, jj = j % tpr, m0 = (t0 >> sh) + 32 * jj;
            const int t = ((m0 + r) << sh) + res;
            bf16x8 qf[4];
            load_q(qf, Q0 + ((size_t)bh * S + t) * 64 + 8 * h);
            f32x16 o0, o1;
#pragma unroll
            for (int i = 0; i < 16; ++i) { o0[i] = 0.f; o1[i] = 0.f; }
            float l = 0.f;
            const int kfirst = m0 - 128;
            const float NEGI = -__builtin_inff();
            bf16x8 kf[5][4];
#pragma unroll
            for (int i = 0; i < 5; ++i) {
                const int kt = kfirst + 32 * i, ktc = kt < 0 ? 0 : kt;
                load_q(kf[i], K0 + ((size_t)bh * S + (((ktc + kperm(r)) << sh) + res)) * 64 + 8 * h);
            }
            f32x16 xs[5];
#pragma unroll
            for (int i = 0; i < 5; ++i) {
                const float offs = (kfirst + 32 * i < 0) ? NEGI : mb2;
#pragma unroll
                for (int e = 0; e < 16; ++e) xs[i][e] = offs;
#pragma unroll
                for (int sp = 0; sp < 4; ++sp) xs[i] = mfma32(kf[i][sp], qf[sp], xs[i]);
            }
#pragma unroll
            for (int i = 0; i < 5; ++i) {
                const int kt = kfirst + 32 * i, ktc = kt < 0 ? 0 : kt;
                bf16x8 vf[2][2];
                load_v(vf, Vs + (size_t)r * S + (size_t)res * L + ktc + 8 * h);
                float p[16];
#pragma unroll
                for (int e = 0; e < 16; ++e) {
                    float v = ex2(xs[i][e]);
                    const int c = kidx(e, h);
                    if ((i == 0 && c < r) || (i == 4 && c > r)) v = 0.f;
                    p[e] = v;
                }
#pragma unroll
                for (int e = 0; e < 16; ++e) l += p[e];
                pv_tile(o0, o1, vf, p);
            }
            l += shx<32>(l);
            const int tl = t - t0;
#pragma unroll
            for (int dd = 0; dd < 2; ++dd)
#pragma unroll
                for (int g = 0; g < 4; ++g) {
                    LAS f32x4* pp = (LAS f32x4*)(Oacc + tl * 68 + 32 * dd + 8 * g + 4 * h);
                    f32x4 cur = *pp;
#pragma unroll
                    for (int e = 0; e < 4; ++e) cur[e] += (dd == 0 ? o0[4 * g + e] : o1[4 * g + e]);
                    *pp = cur;
                }
            if (h == 0) lacc[tl] += l;
        }
        __syncthreads();
    }
    {
        const int t = t0 + tid; const size_t row = (size_t)(bh >> 3) * S + t; const int col0 = (bh & 7) * 64;
        const float inv = 1.0f / lacc[tid];
#pragma unroll
        for (int c8 = 0; c8 < 8; ++c8) {
            const f32x4 a0 = *(LAS f32x4*)(Oacc + tid * 68 + 8 * c8), a1 = *(LAS f32x4*)(Oacc + tid * 68 + 8 * c8 + 4);
            const bf16x8 gt = *(const bf16x8*)(G + row * DM + col0 + 8 * c8);
            f32x8 o;
#pragma unroll
            for (int e = 0; e < 4; ++e) { o[e] = a0[e] * inv * bf2f((unsigned short)gt[e]); o[4 + e] = a1[e] * inv * bf2f((unsigned short)gt[4 + e]); }
            *(bf16x8*)(Y + row * DM + col0 + 8 * c8) = pack8(o);
        }
    }
    __syncthreads();
}

#define XB_TMO      128
#define XB_XCNT(j)  (256  + 64 * (j))
#define XB_XSUB(j)  (1280 + 64 * (j))
#define XB_XGEN(j)  (2304 + 64 * (j))
#define XB_TOP      3328
#define XB_TOPGEN   3392
#define XCD_BAR_WORDS 3456
#define XB_SPIN_CAP (1u << 18)

__device__ __forceinline__ unsigned xb_ld(unsigned* p)              { return __hip_atomic_load(p, __ATOMIC_RELAXED, __HIP_MEMORY_SCOPE_AGENT); }
__device__ __forceinline__ unsigned xb_add(unsigned* p, unsigned v) { return __hip_atomic_fetch_add(p, v, __ATOMIC_RELAXED, __HIP_MEMORY_SCOPE_AGENT); }
__device__ __forceinline__ unsigned xb_xcc_id() { return (unsigned)__builtin_amdgcn_s_getreg((3 << 11) | 20) & 0xFu; }
#define XB_SPIN(cond, bar) do { unsigned _sp = 0; while (cond) { __builtin_amdgcn_s_sleep(1); \
    if ((++_sp & 255u) == 0u) { if (xb_ld(&(bar)[XB_TMO])) break; if (_sp > XB_SPIN_CAP) { atomicAdd(&(bar)[XB_TMO], 1u); break; } } } } while (0)

struct XcdBarrier {
    unsigned* bar; unsigned x;
    volatile LAS unsigned* st;
};

__device__ __forceinline__ XcdBarrier xcd_barrier_post(unsigned* bar, volatile LAS unsigned* st) {
    XcdBarrier b; b.bar = bar; b.x = xb_xcc_id(); b.st = st;
    if (threadIdx.x == 0) (void)xb_add(&bar[XB_XCNT(b.x)], 1u);
    return b;
}
__device__ __forceinline__ void xcd_barrier_complete(unsigned* bar, unsigned x, unsigned& nloc, unsigned& nx) {
    const unsigned G = gridDim.x * gridDim.y * gridDim.z;
    unsigned sum, cnt, mine, sp = 0u;
    for (;;) {
        sum = 0u; cnt = 0u; mine = 0u;
#pragma unroll
        for (unsigned j = 0; j < 16; ++j) { const unsigned c = xb_ld(&bar[XB_XCNT(j)]); sum += c; cnt += (c > 0u) ? 1u : 0u; mine = (j == x) ? c : mine; }
        if (sum == G) break;
        __builtin_amdgcn_s_sleep(1);
        if ((++sp & 255u) == 0u) { if (xb_ld(&bar[XB_TMO])) break; if (sp > XB_SPIN_CAP) { atomicAdd(&bar[XB_TMO], 1u); break; } }
    }
    nloc = mine > 0u ? mine : 1u; nx = cnt > 0u ? cnt : 1u;
}

__device__ __forceinline__ void xcd_barrier(const XcdBarrier& b) {
    asm volatile("s_waitcnt vmcnt(0)" ::: "memory");
    __syncthreads();
    if (threadIdx.x == 0) {
        unsigned* bar = b.bar;
        __builtin_amdgcn_s_waitcnt(0);
        unsigned nloc = b.st[0], nx = b.st[1];
        if (nloc == 0u) { xcd_barrier_complete(bar, b.x, nloc, nx); b.st[0] = nloc; b.st[1] = nx; }
        const unsigned old = xb_add(&bar[XB_XSUB(b.x)], 1u);
        const unsigned gen = old / nloc;
        if (old + 1u == (gen + 1u) * nloc) {
            __builtin_amdgcn_fence(__ATOMIC_RELEASE, "agent");
            asm volatile("s_waitcnt vmcnt(0)" ::: "memory");
            const unsigned og = xb_add(&bar[XB_TOP], 1u);
            const unsigned tg = og / nx;
            if (og + 1u == (tg + 1u) * nx) xb_add(&bar[XB_TOPGEN], 1u);
            else XB_SPIN(xb_ld(&bar[XB_TOPGEN]) == tg, bar);
            __builtin_amdgcn_fence(__ATOMIC_ACQUIRE, "agent");
            xb_add(&bar[XB_XGEN(b.x)], 1u);
            asm volatile("s_waitcnt vmcnt(0)" ::: "memory");
        } else {
            XB_SPIN(xb_ld(&bar[XB_XGEN(b.x)]) == gen, bar);
            __builtin_amdgcn_fence(__ATOMIC_ACQUIRE, "agent");
            asm volatile("s_waitcnt vmcnt(0)" ::: "memory");
        }
    }
    __syncthreads();
}

#ifndef REP_A
#define REP_A 1
#endif
#ifndef REP_CD
#define REP_CD 1
#endif
#ifndef REP_B
#define REP_B 1
#endif
#ifndef REP_G1
#define REP_G1 1
#endif
#ifndef REP_G2
#define REP_G2 1
#endif
#ifndef REP_N
#define REP_N 1
#endif
#ifndef REP_P
#define REP_P 1
#endif
__global__ void __launch_bounds__(512, 2) mega_fwd(Args a) {
    extern __shared__ __attribute__((aligned(16))) unsigned char lds_raw[];
    LAS unsigned char* lds = (LAS unsigned char*)lds_raw;
    cg::grid_group grid = cg::this_grid();
    if (threadIdx.x == 0) { ((volatile LAS unsigned*)(lds + 147300))[0] = 0u; ((volatile LAS unsigned*)(lds + 147300))[1] = 0u; }
    __syncthreads();
    (void)xcd_barrier_post((unsigned*)(a.ws + WS_CTL) + 12288, (volatile LAS unsigned*)(lds + 147300));
#define GSYNC() do { const __attribute__((address_space(4))) Args* ap2 = (const __attribute__((address_space(4))) Args*)__builtin_amdgcn_kernarg_segment_ptr(); asm volatile("" : "+s"(ap2)); \
        XcdBarrier xb_; xb_.bar = (unsigned*)(ap2->ws + WS_CTL) + 12288; xb_.x = xb_xcc_id(); xb_.st = (volatile LAS unsigned*)(lds + 147300); xcd_barrier(xb_); } while (0)
#define WSP(T, off) ((T*)(ws + (off)))
#define OPAQUE_WS const __attribute__((address_space(4))) Args* ap = (const __attribute__((address_space(4))) Args*)__builtin_amdgcn_kernarg_segment_ptr(); asm volatile("" : "+s"(ap)); unsigned char* ws = ap->ws; int tid = threadIdx.x; asm volatile("" : "+v"(tid)); const int lane = tid & 63, wave = __builtin_amdgcn_readfirstlane(tid >> 6); int G = gridDim.x; asm volatile("" : "+s"(G)); const int gw = blockIdx.x * 8 + wave, NGW = G * 8; (void)lane; (void)wave; (void)gw; (void)NGW
    {
        OPAQUE_WS;
        bf16_t* WinT = WSP(bf16_t, WS_WIN); bf16_t* WoutT = WSP(bf16_t, WS_WOUT); float* COS = WSP(float, WS_COS); float* SIN = WSP(float, WS_SIN);
        LAS float* scr = (LAS float*)(lds + wave * 16384);
        constexpr int I_IN = 32 * 256, I_OUT = 32 * 64, I_L = I_IN + I_OUT;
        for (int rep = 0; rep < REP_P; ++rep)
        for (int it = gw; it < NL * I_L; it += NGW) {
            const int l = it / I_L; int rr = it % I_L;
            if (rr < I_IN) {
                const int kbk = rr >> 8, nbk = rr & 255, n0 = 32 * nbk;
                const int pns = n0 >> 8, mxs = (pns & 7) >> 1, pnd = (pns & ~7) | ((((mxs & 1) << 1) | (mxs >> 1)) << 1) | (pns & 1);
                const int nd = pnd * 256 + 128 * ((n0 >> 5) & 1) + 32 * ((n0 >> 6) & 3);
                transpose_item(ap->w_in + (size_t)l * DM * NCOL, NCOL, ap->ng + l * DM, WinT + (size_t)l * NPROJ * DM, DM, 64 * kbk, n0, nd, scr, lane);
            } else {
                rr -= I_IN; const int kbk = rr >> 6, nbk = rr & 63;
                transpose_item(ap->w_out + (size_t)l * DM * DM, DM, nullptr, WoutT + (size_t)l * DM * DM, DM, 64 * kbk, 32 * nbk, 32 * nbk, scr, lane);
            }
        }
        {
            float* WF = WSP(float, WS_WF);
            for (int e = blockIdx.x * 512 + tid; e < NL * 4096; e += G * 512) {
                const int l = e >> 12, q = e & 4095, ln = q & 63, hh = (q >> 6) & 1, je = q >> 7, d = 256 * (je >> 2) + 4 * ln + (je & 3);
                const float g = ap->ng[l * DM + d];
                const f32x4 w = *(const f32x4*)(ap->w_in + (size_t)l * DM * NCOL + (size_t)d * NCOL + NPROJ + 4 * hh);
                ((f32x4*)WF)[e] = w * g;
            }
        }
        for (int e = blockIdx.x * 512 + tid; e < S * 32; e += G * 512) {
            const int pos = e >> 5, j = e & 31;
            const float ang = (float)pos * ap->inv_freq[j];
            const double rev = (double)ang * 0.15915494309189535;
            const float fr = (float)(rev - floor(rev));
            COS[e] = __builtin_amdgcn_cosf(fr); SIN[e] = __builtin_amdgcn_sinf(fr);
        }
    }

#pragma unroll 1
    for (int l = 0; l < NL; ++l) {
        {
            OPAQUE_WS;
            bf16_t* XB = WSP(bf16_t, WS_XB); float* LOGF = WSP(float, WS_LOGF);
            const float* src = (l == 0) ? ap->x : ap->out;
            if (l == 0) grid.sync();
            {
                const f32x4* WFg = (const f32x4*)WSP(float, WS_WF) + (size_t)l * 4096;
                LAS f32x4* wfl = (LAS f32x4*)lds;
#pragma unroll
                for (int i = 0; i < 8; ++i) wfl[tid + 512 * i] = WFg[tid + 512 * i];
                __syncthreads();
            }
            for (int rep = 0; rep < REP_N; ++rep)
            for (int m = gw; m < MT; m += NGW) {
                const int b = m / S, s = m % S;
                norm_row(src + (size_t)m * DM, (const LAS f32x4*)lds, ap->fb + l * 8, XB + (size_t)m * DM, LOGF + (size_t)b * 8 * S, s, lane);
            }
        }
        GSYNC();
        if (blockIdx.x < 16) {
            OPAQUE_WS;
            float* LOGF = WSP(float, WS_LOGF); float* FB = WSP(float, WS_F);
            const int bh = blockIdx.x;
            const float* lf = LOGF + (size_t)bh * S + tid * 16;
            float v[16];
#pragma unroll
            for (int i = 0; i < 4; ++i) { const f32x4 t = ((const f32x4*)lf)[i]; v[4 * i] = t[0]; v[4 * i + 1] = t[1]; v[4 * i + 2] = t[2]; v[4 * i + 3] = t[3]; }
            double tot = 0.0;
#pragma unroll
            for (int i = 0; i < 16; ++i) tot += (double)v[i];
            double inc = tot;
#pragma unroll
            for (int o = 1; o < 64; o <<= 1) { const double t = __shfl_up(inc, o); if (lane >= o) inc += t; }
            LAS double* wt = (LAS double*)lds;
            if (lane == 63) wt[wave] = inc;
            __syncthreads();
            double base = inc - tot;
            for (int w = 0; w < wave; ++w) base += wt[w];
            float* fo = FB + (size_t)bh * S + tid * 16;
            double run = base;
#pragma unroll
            for (int i = 0; i < 4; ++i) { f32x4 t; for (int e = 0; e < 4; ++e) { run += (double)v[4 * i + e]; t[e] = (float)run; } ((f32x4*)fo)[i] = t; }
            __syncthreads();
        }
        {
            OPAQUE_WS;
            bf16_t* WinT = WSP(bf16_t, WS_WIN); bf16_t* XB = WSP(bf16_t, WS_XB); bf16_t* Qb = WSP(bf16_t, WS_Q); bf16_t* Kb = WSP(bf16_t, WS_K); bf16_t* VT = WSP(bf16_t, WS_VT); bf16_t* VTX = WSP(bf16_t, WS_VTX);
            bf16_t* Gb = WSP(bf16_t, WS_G); float* KMP = WSP(float, WS_KMP); float* COS = WSP(float, WS_COS); float* SIN = WSP(float, WS_SIN);
            pg8::Gemm g{XB, WinT + (size_t)l * NPROJ * DM, MT, NPROJ, DM}; pg8::StaticOrder So; So.init(MT, NPROJ, G, (int)blockIdx.x);
            EpiIn E{Qb, Kb, VT, VTX, Gb, KMP, ap->qg + l * 192, ap->kg + l * 192, COS, SIN};
            for (int rep = 0; rep < REP_G1; ++rep) pg8::gemm_phase<EpiIn, pg8::StaticOrder, true, true>(lds, g, So, E);
        }
        GSYNC();
        {
            OPAQUE_WS;
            unsigned* ctl = WSP(unsigned, WS_CTL); bf16_t* Qb = WSP(bf16_t, WS_Q); bf16_t* Kb = WSP(bf16_t, WS_K); bf16_t* VT = WSP(bf16_t, WS_VT); bf16_t* VTX = WSP(bf16_t, WS_VTX);
            bf16_t* Gb = WSP(bf16_t, WS_G); bf16_t* Yb = WSP(bf16_t, WS_Y); float* FB = WSP(float, WS_F); float* KMP = WSP(float, WS_KMP);
            float Mx[3];
#pragma unroll
            for (int gi = 0; gi < 3; ++gi) {
                const float gq = wave_max(fabsf(ap->qg[l * 192 + gi * 64 + lane])), gk = wave_max(fabsf(ap->kg[l * 192 + gi * 64 + lane]));
                Mx[gi] = 8.1f * gq * gk;
            }
            LAS float* Oacc = (LAS float*)lds; LAS float* lacc = (LAS float*)(lds + 512 * 68 * 4);
            const int xcc = (int)(__builtin_amdgcn_s_getreg((3 << 11) | 20) & 7u);
            const int vb = (G == 256) ? ((int)(blockIdx.x & 7) * 32 + (int)(blockIdx.x >> 3)) : (int)blockIdx.x;
            for (int rep = 0; rep < REP_A; ++rep)
            for (int it = vb; it < 256; it += G)
                attn_A_item(Qb, Kb, VT, VTX, Gb, Yb, it >> 4, it & 15, Mx[0], Oacc, lacc, tid, wave, lane);
            for (int rep = 0; rep < REP_CD; ++rep) {
                LAS int* qw = (LAS int*)(lds + 147200);
                for (int sq = 0; sq < 8; ++sq) {
                    const int q = (xcc + sq) & 7;
                    unsigned* ctr = ctl + 64 * (l * 16 + q) + 1024 * 4 * rep;
                    for (;;) {
                        if (tid == 0) *qw = (int)atomicAdd(ctr, 1u);
                        __syncthreads();
                        const int idx = __builtin_amdgcn_readfirstlane(*qw);
                        __syncthreads();
                        if (idx >= 72) break;
                        const int k = idx >> 2, j = idx & 3, bh = 2 * q + (j >> 1), halfq = (k >= 6 && k < 10), qb2 = k < 6 ? 13 - k : (halfq ? 37 - k : 17 - k);
                        if (j & 1) attn_wg2_item<3>(Qb + (size_t)3 * 16 * S * 64, Kb + (size_t)3 * 16 * S * 64, VT + (size_t)3 * 16 * 64 * S, FB + (size_t)bh * S, nullptr, Gb, Yb, bh, qb2, halfq, 3, Mx[2], lds, tid, wave, lane);
                        else attn_wg2_item<2>(Qb + (size_t)2 * 16 * S * 64, Kb + (size_t)2 * 16 * S * 64, VT + (size_t)2 * 16 * 64 * S, nullptr, KMP + (size_t)bh * 32 * 2 * 64, Gb, Yb, bh, qb2, halfq, 2, Mx[1], lds, tid, wave, lane);
                    }
                }
            }
            for (int rep = 0; rep < REP_B; ++rep) {
                LAS int* qw = (LAS int*)(lds + 147200);
                for (int sq = 0; sq < 8; ++sq) {
                    const int q = (xcc + sq) & 7;
                    unsigned* ctr = ctl + 64 * (l * 16 + 8 + q) + 1024 * 4 * rep;
                    for (;;) {
                        if (tid == 0) *qw = (int)atomicAdd(ctr, 1u);
                        __syncthreads();
                        const int idx = __builtin_amdgcn_readfirstlane(*qw);
                        __syncthreads();
                        if (idx >= 64) break;
                        const int qb = 31 - (idx >> 1), bh = 2 * q + (idx & 1);
                        attn_wgB_item(Qb + (size_t)1 * 16 * S * 64, Kb + (size_t)1 * 16 * S * 64, VT + (size_t)1 * 16 * 64 * S, Gb, Yb, bh, qb, 1, lds, tid, wave, lane);
                    }
                }
            }
        }
        GSYNC();
        {
            OPAQUE_WS;
            bf16_t* WoutT = WSP(bf16_t, WS_WOUT); bf16_t* Yb = WSP(bf16_t, WS_Y);
            pg8::Gemm g{Yb, WoutT + (size_t)l * DM * DM, MT, DM, DM}; pg8::StaticOrder So; So.init(MT, DM, G, (int)blockIdx.x);
            EpiOut E{(l == 0) ? ap->x : ap->out, ap->out};
            for (int rep = 0; rep < (REP_G2 > 1 && l == 0 ? REP_G2 : 1); ++rep) pg8::gemm_phase<EpiOut, pg8::StaticOrder, true, true>(lds, g, So, E);
        }
        if (l + 1 < NL) GSYNC();
    }
}

extern "C" void kernel_launch(void* const* d_in, const int* in_sizes, int n_in, void* d_out, int out_size, void* d_ws, size_t ws_size, hipStream_t stream) {
    static int grid = 0;
    if (grid == 0) {
        if (n_in != 7 || out_size != MT * DM || ws_size < WS_END) { fprintf(stderr, "kernel_launch: unexpected shapes (n_in %d out %d ws %zu)\n", n_in, out_size, ws_size); grid = -1; return; }
        int dev = 0, cus = 0, per_cu = 0;
        hipGetDevice(&dev); hipDeviceGetAttribute(&cus, hipDeviceAttributeMultiprocessorCount, dev);
        if (hipFuncSetAttribute((const void*)mega_fwd, hipFuncAttributeMaxDynamicSharedMemorySize, LDS_BYTES) != hipSuccess) { fprintf(stderr, "kernel_launch: hipFuncSetAttribute failed\n"); grid = -1; return; }
        if (hipOccupancyMaxActiveBlocksPerMultiprocessor(&per_cu, (const void*)mega_fwd, 512, LDS_BYTES) != hipSuccess || per_cu < 1) { fprintf(stderr, "kernel_launch: occupancy query says %d\n", per_cu); per_cu = 1; }
        (void)hipGetLastError();
        grid = cus * per_cu;
    }
    if (grid < 0) return;
    hipMemsetAsync((char*)d_ws + WS_CTL, 0, CTL_BYTES, stream);
    Args a{};
    a.x = (const float*)d_in[0]; a.ng = (const float*)d_in[1]; a.w_in = (const float*)d_in[2]; a.qg = (const float*)d_in[3]; a.kg = (const float*)d_in[4];
    a.fb = (const float*)d_in[5]; a.w_out = (const float*)d_in[6]; a.out = (float*)d_out; a.ws = (unsigned char*)d_ws;
    for (int j = 0; j < 32; ++j) a.inv_freq[j] = (float)(1.0 / pow(10000.0, (double)j / 32.0));
    void* args[] = {&a};
    hipError_t e = hipLaunchCooperativeKernel((const void*)mega_fwd, dim3(grid), dim3(512), args, LDS_BYTES, stream);
    if (e != hipSuccess) fprintf(stderr, "kernel_launch: cooperative launch failed: %s (grid %d)\n", hipGetErrorString(e), grid);
}
```

```cpp
#include <hip/hip_runtime.h>
#include <hip/hip_cooperative_groups.h>
#include <cstdio>
#include <cstdint>
#include <cmath>
namespace cg = cooperative_groups;
namespace pg8 {
#define PG8_LAS __attribute__((address_space(3)))
typedef unsigned short bf16_t;
typedef short bf16x8 __attribute__((ext_vector_type(8)));
typedef float f32x4 __attribute__((ext_vector_type(4)));
typedef unsigned u32x4 __attribute__((ext_vector_type(4)));
constexpr int BM = 256, BK = 64, HALF = 128, HTB = HALF * BK * 2  , STAGE_BYTES = 8 * HTB, NXCD = 8, WGM = 8;

__host__ __device__ __forceinline__ int lds_byte(int r, int c) { const int st = (r >> 4) * 2 + (c >> 5), rr = r & 15, cc = c & 31, ob = rr * 64 + cc * 2; return st * 1024 + (ob ^ (((ob >> 9) & 1) << 5)); }
__host__ __device__ __forceinline__ void stage_rc(int b, int& R, int& C) { const int st = b / 1024, sb = b % 1024, swz = sb ^ (((sb >> 9) & 1) << 5); R = (st >> 1) * 16 + swz / 64; C = (st & 1) * 32 + (swz % 64) / 2; }
__host__ __device__ __forceinline__ int perm32(int rho) { const int n = rho >> 4, i = rho & 15; return 8 * (i >> 2) + 4 * n + (i & 3); }

struct Unit { int pm, pn; };
struct Gemm { const bf16_t* A; const bf16_t* Bt; int M, N, K; };

struct StaticOrder {
    int nM, nN, nwg, G, c;
    __host__ __device__ void init(int M, int N, int G_, int c_) { nM = M / BM; nN = N / BM; nwg = nM * nN; G = G_; c = c_; }
    __host__ __device__ bool next(int i, Unit& u) const {
        const long L = (long)i * G + c; if (L >= nwg) return false;
        int wgid = (int)L; { const int q = nwg / NXCD, r = nwg % NXCD, xcd = wgid % NXCD, off = wgid / NXCD; wgid = (xcd < r ? xcd * (q + 1) : r * (q + 1) + (xcd - r) * q) + off; }
        const int nig = WGM * nN, gid = wgid / nig, fm = gid * WGM, gsz = (nM - fm) < WGM ? (nM - fm) : WGM;
        u.pm = fm + ((wgid % nig) % gsz); u.pn = (wgid % nig) / gsz; return true;
    }
    __device__ __forceinline__ void a_ready(const Unit&) const {}
    __device__ __forceinline__ void done(const Unit&) const {}
};

__device__ __forceinline__ unsigned cvt_pk_bf16(float lo, float hi) { unsigned r; asm volatile("v_cvt_pk_bf16_f32 %0, %1, %2" : "=v"(r) : "v"(lo), "v"(hi)); return r; }
typedef float f32x2 __attribute__((ext_vector_type(2)));
template <class Epi, class Sched, bool ALIGN_EPI = false, bool SP2 = false>
__device__ __forceinline__ void gemm_phase(PG8_LAS unsigned char* lds, const Gemm g, const Sched& S, const Epi& E) {
    int tid_ = threadIdx.x; asm volatile("" : "+v"(tid_));
    const int tid = tid_, wid = __builtin_amdgcn_readfirstlane(tid >> 6), lane = tid & 63, wr = wid >> 2, wc = wid & 3, fr = lane & 15, fq = lane >> 4;
    const int K = g.K, nt = K / BK;
    unsigned voffA[2], voffB[2];
#pragma unroll
    for (int i = 0; i < 2; ++i) { int R, C; stage_rc(tid * 16 + i * 8192, R, C); const int Rb = Epi::PERM ? ((R & ~31) + perm32(R & 31)) : R;
        voffA[i] = (unsigned)(R * K + C) * 2u; voffB[i] = (unsigned)(Rb * K + C) * 2u; }
    const size_t kstep = (size_t)(BK * 2);
    const size_t hstep = (size_t)HALF * K * 2;
    const size_t tstep = 2 * hstep;
    const unsigned ldsw = (unsigned)wid * 1024u;
    const int aoff = lds_byte(wr * 64 + fr, fq * 8), boff = lds_byte(wc * 32 + fr, fq * 8);
#define PG8_SA(b, h) (((b) * 2 + (h)) * HTB)
#define PG8_SB(b, h) ((4 + (b) * 2 + (h)) * HTB)
#define PG8_STAGE(bufoff, gbase, voff) do { _Pragma("unroll") for (int _i = 0; _i < 2; ++_i) \
        __builtin_amdgcn_global_load_lds((const unsigned*)((const char*)(gbase) + (voff)[_i]), (PG8_LAS unsigned*)(lds + (bufoff) + ldsw + _i * 8192), 16, 0, 0); } while (0)
#define PG8_LDA(dst, b, h) do { _Pragma("unroll") for (int m = 0; m < 4; ++m) _Pragma("unroll") for (int k = 0; k < 2; ++k) dst[m][k] = *(const PG8_LAS bf16x8*)(lds + PG8_SA(b, h) + aoff + m * 2048 + k * 1024); } while (0)
#define PG8_LDB(dst, b, h) do { _Pragma("unroll") for (int n = 0; n < 2; ++n) _Pragma("unroll") for (int k = 0; k < 2; ++k) dst[n][k] = *(const PG8_LAS bf16x8*)(lds + PG8_SB(b, h) + boff + n * 2048 + k * 1024); } while (0)
#define PG8_MMA(ai, bj, At, Bt) do { __builtin_amdgcn_s_setprio(1); _Pragma("unroll") for (int m = 0; m < 4; ++m) _Pragma("unroll") for (int n = 0; n < 2; ++n) _Pragma("unroll") for (int k = 0; k < 2; ++k) \
        acc[ai][bj][m][n] = __builtin_amdgcn_mfma_f32_16x16x32_bf16(Bt[n][k], At[m][k], acc[ai][bj][m][n], 0, 0, 0); __builtin_amdgcn_s_setprio(0); } while (0)
#define PG8_WAIT_V(n) asm volatile("s_waitcnt vmcnt(" #n ")" ::: "memory")
#define PG8_WAIT_L(n) asm volatile("s_waitcnt lgkmcnt(" #n ")" ::: "memory")
#define PG8_BAR __builtin_amdgcn_s_barrier()
#define PG8_SCHED __builtin_amdgcn_sched_barrier(0)
    Unit cur, nxt; int ui = 0;
    if (!S.next(0, cur)) return;
    f32x4 acc[2][2][4][2];
#pragma unroll
    for (int a = 0; a < 2; ++a)
#pragma unroll
        for (int b = 0; b < 2; ++b)
#pragma unroll
            for (int m = 0; m < 4; ++m)
#pragma unroll
                for (int n = 0; n < 2; ++n) acc[a][b][m][n] = (f32x4){0.f, 0.f, 0.f, 0.f};
    bf16x8 At[4][2], B0[2][2], B1[2][2];
    const char* cA = (const char*)g.A + (size_t)cur.pm * tstep; const char* cB = (const char*)g.Bt + (size_t)cur.pn * tstep;
    S.a_ready(cur);
    if constexpr (SP2) {
        PG8_STAGE(PG8_SB(0, 0), cB, voffB); PG8_STAGE(PG8_SB(0, 1), cB + hstep, voffB); PG8_STAGE(PG8_SA(0, 0), cA, voffA); PG8_STAGE(PG8_SA(0, 1), cA + hstep, voffA);
        if (wr == 1) PG8_BAR;
        PG8_WAIT_V(2); PG8_BAR;
        PG8_STAGE(PG8_SB(1, 0), cB + kstep, voffB); PG8_STAGE(PG8_SA(1, 0), cA + kstep, voffA); PG8_STAGE(PG8_SB(1, 1), cB + hstep + kstep, voffB);
        PG8_WAIT_V(6); PG8_BAR;
    } else {
        PG8_STAGE(PG8_SB(0, 0), cB, voffB); PG8_STAGE(PG8_SA(0, 0), cA, voffA); PG8_STAGE(PG8_SB(0, 1), cB + hstep, voffB); PG8_STAGE(PG8_SA(0, 1), cA + hstep, voffA);
        if (wr == 1) PG8_BAR;
        PG8_WAIT_V(4); PG8_BAR;
        PG8_STAGE(PG8_SB(1, 0), cB + kstep, voffB); PG8_STAGE(PG8_SA(1, 0), cA + kstep, voffA); PG8_STAGE(PG8_SB(1, 1), cB + hstep + kstep, voffB);
        PG8_WAIT_V(6); PG8_BAR;
    }
    for (;;) {
        const bool has_next = S.next(ui + 1, nxt);
        const char* nA = has_next ? (const char*)g.A + (size_t)nxt.pm * tstep : cA; const char* nB = has_next ? (const char*)g.Bt + (size_t)nxt.pn * tstep : cB;
        for (int t = 0; t < nt; t += 2) {
            const bool last = (t == nt - 2);
            const char* a1 = cA + (size_t)(t + 1) * kstep;
            const char* a2 = last ? nA : cA + (size_t)(t + 2) * kstep; const char* b2 = last ? nB : cB + (size_t)(t + 2) * kstep;
            const char* a3 = a2 + kstep; const char* b3 = b2 + kstep;
            if (last && has_next) S.a_ready(nxt);
            if constexpr (SP2) {
            PG8_LDB(B0, 0, 0); PG8_LDB(B1, 0, 1); PG8_SCHED; PG8_LDA(At, 0, 0); PG8_STAGE(PG8_SA(1, 1), a1 + hstep, voffA);
            PG8_WAIT_V(8); PG8_WAIT_L(0); PG8_BAR; PG8_MMA(0, 0, At, B0); PG8_MMA(0, 1, At, B1); PG8_BAR; PG8_SCHED;
            PG8_LDA(At, 0, 1); PG8_STAGE(PG8_SB(0, 0), b2, voffB); PG8_STAGE(PG8_SB(0, 1), b2 + hstep, voffB); PG8_STAGE(PG8_SA(0, 0), a2, voffA);
            PG8_WAIT_V(8); PG8_WAIT_L(0); PG8_BAR; PG8_MMA(1, 0, At, B0); PG8_MMA(1, 1, At, B1); PG8_BAR; PG8_SCHED;
            PG8_LDB(B0, 1, 0); PG8_LDB(B1, 1, 1); PG8_SCHED; PG8_LDA(At, 1, 0); PG8_STAGE(PG8_SA(0, 1), a2 + hstep, voffA);
            PG8_WAIT_V(8); PG8_WAIT_L(0); PG8_BAR; PG8_MMA(0, 0, At, B0); PG8_MMA(0, 1, At, B1); PG8_BAR; PG8_SCHED;
            PG8_LDA(At, 1, 1); PG8_STAGE(PG8_SB(1, 0), b3, voffB); PG8_STAGE(PG8_SB(1, 1), b3 + hstep, voffB); PG8_STAGE(PG8_SA(1, 0), a3, voffA);
            PG8_WAIT_V(8); PG8_WAIT_L(0); PG8_BAR; PG8_MMA(1, 0, At, B0); PG8_MMA(1, 1, At, B1); PG8_BAR; PG8_SCHED;
            } else {
            PG8_LDB(B0, 0, 0); PG8_SCHED; PG8_LDA(At, 0, 0); PG8_STAGE(PG8_SA(1, 1), a1 + hstep, voffA);
            PG8_WAIT_L(8); PG8_BAR; PG8_WAIT_L(0); PG8_MMA(0, 0, At, B0); PG8_BAR; PG8_SCHED;
            PG8_LDB(B1, 0, 1); PG8_STAGE(PG8_SB(0, 0), b2, voffB);
            PG8_BAR; PG8_WAIT_L(0); PG8_MMA(0, 1, At, B1); PG8_BAR;
            PG8_LDA(At, 0, 1); PG8_STAGE(PG8_SA(0, 0), a2, voffA);
            PG8_BAR; PG8_WAIT_L(0); PG8_MMA(1, 0, At, B0); PG8_BAR; PG8_SCHED;
            PG8_STAGE(PG8_SB(0, 1), b2 + hstep, voffB);
            PG8_WAIT_V(6); PG8_BAR; PG8_MMA(1, 1, At, B1); PG8_BAR;
            PG8_LDB(B0, 1, 0); PG8_SCHED; PG8_LDA(At, 1, 0); PG8_STAGE(PG8_SA(0, 1), a2 + hstep, voffA);
            PG8_WAIT_L(8); PG8_BAR; PG8_WAIT_L(0); PG8_MMA(0, 0, At, B0); PG8_BAR; PG8_SCHED;
            PG8_LDB(B1, 1, 1); PG8_STAGE(PG8_SB(1, 0), b3, voffB);
            PG8_BAR; PG8_WAIT_L(0); PG8_MMA(0, 1, At, B1); PG8_BAR;
            PG8_LDA(At, 1, 1); PG8_STAGE(PG8_SA(1, 0), a3, voffA);
            PG8_BAR; PG8_WAIT_L(0); PG8_MMA(1, 0, At, B0); PG8_BAR; PG8_SCHED;
            PG8_STAGE(PG8_SB(1, 1), b3 + hstep, voffB);
            PG8_WAIT_V(6); PG8_BAR; PG8_MMA(1, 1, At, B1); PG8_BAR;
            }
        }
        if constexpr (ALIGN_EPI) { if (wr == 0) PG8_BAR; }
        if constexpr (!Epi::AFTER_DRAIN) { E(acc, cur, wr, wc, fr, fq); S.done(cur); }
        if (!has_next) break;
#pragma unroll
        for (int a = 0; a < 2; ++a)
#pragma unroll
            for (int b = 0; b < 2; ++b)
#pragma unroll
                for (int m = 0; m < 4; ++m)
#pragma unroll
                    for (int n = 0; n < 2; ++n) acc[a][b][m][n] = (f32x4){0.f, 0.f, 0.f, 0.f};
        cur = nxt; cA = nA; cB = nB; ++ui;
        if constexpr (ALIGN_EPI) { if (wr == 1) PG8_BAR; }
    }
    PG8_WAIT_V(0);
    if constexpr (!ALIGN_EPI) { if (wr == 0) PG8_BAR; }
    PG8_BAR;
    if constexpr (Epi::AFTER_DRAIN) { E.fused(acc, cur, wr, wc, fr, fq, lds, wid, lane); S.done(cur); }
#undef PG8_SA
#undef PG8_SB
#undef PG8_STAGE
#undef PG8_LDA
#undef PG8_LDB
#undef PG8_MMA
#undef PG8_WAIT_V
#undef PG8_WAIT_L
#undef PG8_BAR
#undef PG8_SCHED
}
}

#define DI __device__ __forceinline__
#define LAS __attribute__((address_space(3)))
typedef unsigned short bf16_t;
typedef short bf16x8 __attribute__((ext_vector_type(8)));
typedef short s16x4 __attribute__((ext_vector_type(4)));
typedef float f32x4 __attribute__((ext_vector_type(4)));
typedef float f32x8 __attribute__((ext_vector_type(8)));
typedef float f32x16 __attribute__((ext_vector_type(16)));
typedef unsigned u32x4 __attribute__((ext_vector_type(4)));
typedef unsigned u32x2 __attribute__((ext_vector_type(2)));
typedef __bf16 bf8v __attribute__((ext_vector_type(8)));
typedef __bf16 bf4v __attribute__((ext_vector_type(4)));

constexpr int NB = 2, S = 8192, DM = 2048, MT = NB * S, NL = 4, HD = 64, NCOL = 8200, NPROJ = 8192;
constexpr float LOG2E = 1.4426950408889634f, LN2 = 0.6931471805599453f;
constexpr size_t MiB = 1u << 20;
constexpr size_t WS_CTL = 0, CTL_BYTES = 65536;
constexpr size_t WS_WIN = 1 * MiB;
constexpr size_t WS_WOUT = 129 * MiB;
constexpr size_t WS_XB = 161 * MiB;
constexpr size_t WS_Q = 225 * MiB;
constexpr size_t WS_K = 289 * MiB;
constexpr size_t WS_VT = 353 * MiB;
constexpr size_t WS_VTX = 417 * MiB;
constexpr size_t WS_G = 449 * MiB;
constexpr size_t WS_Y = 513 * MiB;
constexpr size_t WS_LOGF = 577 * MiB;
constexpr size_t WS_F = WS_LOGF + 512 * 1024;
constexpr size_t WS_KMP = 578 * MiB;
constexpr size_t WS_COS = 579 * MiB, WS_SIN = 580 * MiB;
constexpr size_t WS_WF = 581 * MiB;
constexpr size_t WS_END = 582 * MiB;
constexpr int LDS_BYTES = 147456;

struct Args { const float *x, *ng, *w_in, *qg, *kg, *fb, *w_out; float* out; unsigned char* ws; float inv_freq[32]; };

DI unsigned f2bf(float f) { unsigned u = __builtin_bit_cast(unsigned, f); return (u + 0x7fffu + ((u >> 16) & 1u)) >> 16; }
DI unsigned pk2(float lo, float hi) { return f2bf(lo) | (f2bf(hi) << 16); }
DI float bf2f(unsigned short b) { return __builtin_bit_cast(float, (unsigned)b << 16); }
DI bf16x8 pack8(f32x8 v) { bf8v b = __builtin_convertvector(v, bf8v); return __builtin_bit_cast(bf16x8, b); }
DI s16x4 pack4(f32x4 v) { bf4v b = __builtin_convertvector(v, bf4v); return __builtin_bit_cast(s16x4, b); }
template <int O> DI int shxi(int v) {
    if constexpr (O < 32) return __builtin_amdgcn_ds_swizzle(v, 0x1f | (O << 10));
    else { const auto r = __builtin_amdgcn_permlane32_swap((unsigned)v, (unsigned)v, false, false); return (int)((threadIdx.x & 32u) ? r[0] : r[1]); }
}
template <int O> DI float shx(float v) { return __builtin_bit_cast(float, shxi<O>(__builtin_bit_cast(int, v))); }
DI float wave_sum(float v) { v += shx<1>(v); v += shx<2>(v); v += shx<4>(v); v += shx<8>(v); v += shx<16>(v); v += shx<32>(v); return v; }
DI float wave_max(float v) { v = fmaxf(v, shx<1>(v)); v = fmaxf(v, shx<2>(v)); v = fmaxf(v, shx<4>(v)); v = fmaxf(v, shx<8>(v)); v = fmaxf(v, shx<16>(v)); v = fmaxf(v, shx<32>(v)); return v; }
DI f32x16 mfma32(bf16x8 a, bf16x8 b, f32x16 c) { return __builtin_amdgcn_mfma_f32_32x32x16_bf16(a, b, c, 0, 0, 0); }
DI float ex2(float x) { return __builtin_amdgcn_exp2f(x); }
DI float lg2(float x) { return __builtin_amdgcn_logf(x); }

struct EpiIn {
    static constexpr bool PERM = true, AFTER_DRAIN = false;
    bf16_t *Q, *K, *VT, *VTX, *G; float* KMP; const float *qg, *kg, *cosT, *sinT;
    __device__ __forceinline__ void operator()(const pg8::f32x4 (&acc)[2][2][4][2], const pg8::Unit& u, int wr, int wc, int fr, int fq) const {
        const int ms = (u.pn & 7) >> 1, mixer = ((ms & 1) << 1) | (ms >> 1);
        const int sec = u.pn >> 3, head = 4 * (u.pn & 1) + wc;
        const int b = u.pm >> 5, blk = u.pm & 31, sbase = blk * 256 + wr * 64 + fr, bh = b * 8 + head;
        if (sec <= 1) {
            const bool norm = mixer != 1, rope = (mixer == 0 || mixer == 2), km = (sec == 1 && mixer == 2);
            const float* gp = (sec == 0 ? qg : kg) + (mixer == 0 ? 0 : (mixer == 2 ? 1 : 2)) * 64;
            f32x4 gn[2][2], ks[2][2];
#pragma unroll
            for (int bj = 0; bj < 2; ++bj)
#pragma unroll
                for (int n = 0; n < 2; ++n) { gn[bj][n] = norm ? *(const f32x4*)(gp + 32 * bj + 8 * fq + 4 * n) : (f32x4){1.f, 1.f, 1.f, 1.f}; ks[bj][n] = (f32x4){0.f, 0.f, 0.f, 0.f}; }
            bf16_t* dst = (sec == 0 ? Q : K) + (size_t)(mixer * 16 + bh) * S * 64;
            const float osc = sec == 0 ? (mixer == 1 ? 0.125f : 0.125f * LOG2E) : 1.0f;
#pragma unroll
            for (int ai = 0; ai < 2; ++ai)
#pragma unroll
                for (int m = 0; m < 4; ++m) {
                    const int s = sbase + 128 * ai + 16 * m;
                    f32x4 v[2][2];
#pragma unroll
                    for (int bj = 0; bj < 2; ++bj)
#pragma unroll
                        for (int n = 0; n < 2; ++n) v[bj][n] = acc[ai][bj][m][n];
                    if (norm) {
                        float ss = 0.f;
#pragma unroll
                        for (int bj = 0; bj < 2; ++bj)
#pragma unroll
                            for (int n = 0; n < 2; ++n) { const f32x4 t = v[bj][n]; ss += (t[0] * t[0] + t[1] * t[1]) + (t[2] * t[2] + t[3] * t[3]); }
                        ss += shx<16>(ss); ss += shx<32>(ss);
                        const float rr = rsqrtf(ss * (1.0f / 64.0f) + 1e-6f);
#pragma unroll
                        for (int bj = 0; bj < 2; ++bj)
#pragma unroll
                            for (int n = 0; n < 2; ++n) v[bj][n] = v[bj][n] * rr * gn[bj][n];
                    }
                    if (rope) {
#pragma unroll
                        for (int n = 0; n < 2; ++n) {
                            const f32x4 c4 = *(const f32x4*)(cosT + (size_t)s * 32 + 8 * fq + 4 * n), s4 = *(const f32x4*)(sinT + (size_t)s * 32 + 8 * fq + 4 * n);
                            const f32x4 t1 = v[0][n], t2 = v[1][n];
                            v[0][n] = t1 * c4 - t2 * s4; v[1][n] = t2 * c4 + t1 * s4;
                        }
                    }
                    if (km) {
#pragma unroll
                        for (int bj = 0; bj < 2; ++bj)
#pragma unroll
                            for (int n = 0; n < 2; ++n) ks[bj][n] += v[bj][n];
                    }
#pragma unroll
                    for (int bj = 0; bj < 2; ++bj) {
                        const f32x4 a0 = v[bj][0] * osc, a1 = v[bj][1] * osc;
                        const bf16x8 w = pack8((f32x8){a0[0], a0[1], a0[2], a0[3], a1[0], a1[1], a1[2], a1[3]});
                        *(bf16x8*)(dst + (size_t)s * 64 + 32 * bj + 8 * fq) = w;
                    }
                }
            if (km) {
#pragma unroll
                for (int bj = 0; bj < 2; ++bj)
#pragma unroll
                    for (int n = 0; n < 2; ++n) {
                        f32x4 t = ks[bj][n];
#pragma unroll
                        for (int e = 0; e < 4; ++e) { float x = t[e]; x += shx<1>(x); x += shx<2>(x); x += shx<4>(x); x += shx<8>(x); t[e] = x; }
                        if (fr == 0) *(f32x4*)(KMP + ((size_t)(bh * 32 + blk) * 2 + wr) * 64 + 32 * bj + 8 * fq + 4 * n) = t;
                    }
            }
        } else if (sec == 2) {
            bf16_t* vt = VT + (size_t)(mixer * 16 + bh) * 64 * S;
            bf16_t* vx0 = VTX + (size_t)bh * 64 * S;
            bf16_t* vx1 = VTX + (size_t)(16 + bh) * 64 * S;
#pragma unroll
            for (int ai = 0; ai < 2; ++ai)
#pragma unroll
                for (int m = 0; m < 4; ++m) {
                    const int s = sbase + 128 * ai + 16 * m;
                    const int s4 = (s & 3) * (S / 4) + (s >> 2), s16 = (s & 15) * (S / 16) + (s >> 4);
#pragma unroll
                    for (int bj = 0; bj < 2; ++bj)
#pragma unroll
                        for (int n = 0; n < 2; ++n)
#pragma unroll
                            for (int e = 0; e < 4; ++e) {
                                const int d = 32 * bj + 8 * fq + 4 * n + e;
                                const bf16_t w = (bf16_t)f2bf(acc[ai][bj][m][n][e]);
                                vt[(size_t)d * S + s] = w;
                                if (mixer == 0) vx0[(size_t)d * S + s4] = w;
                            }
                }
            if (mixer == 0) {
#pragma unroll
                for (int ai = 0; ai < 2; ++ai) {
                    const int s0 = sbase + 128 * ai, s16 = (s0 & 15) * (S / 16) + (s0 >> 4);
#pragma unroll
                    for (int bj = 0; bj < 2; ++bj)
#pragma unroll
                        for (int n = 0; n < 2; ++n)
#pragma unroll
                            for (int e = 0; e < 4; ++e) {
                                const int d = 32 * bj + 8 * fq + 4 * n + e;
                                const f32x4 t = {acc[ai][bj][0][n][e], acc[ai][bj][1][n][e], acc[ai][bj][2][n][e], acc[ai][bj][3][n][e]};
                                *(s16x4*)(vx1 + (size_t)d * S + s16) = pack4(t);
                            }
                }
            }
        } else {
            const int col = 512 * mixer + 256 * (u.pn & 1) + 64 * wc + 8 * fq;
#pragma unroll
            for (int ai = 0; ai < 2; ++ai)
#pragma unroll
                for (int m = 0; m < 4; ++m) {
                    const size_t row = (size_t)u.pm * 256 + 128 * ai + 64 * wr + 16 * m + fr;
#pragma unroll
                    for (int bj = 0; bj < 2; ++bj) {
                        f32x8 t;
#pragma unroll
                        for (int n = 0; n < 2; ++n)
#pragma unroll
                            for (int e = 0; e < 4; ++e) { const float z = acc[ai][bj][m][n][e]; t[4 * n + e] = z / (1.0f + __expf(-z)); }
                        *(bf16x8*)(G + row * DM + col + 32 * bj) = pack8(t);
                    }
                }
        }
    }
};
struct EpiOut {
    static constexpr bool PERM = false, AFTER_DRAIN = false;
    const float* src; float* out;
    __device__ __forceinline__ void operator()(const pg8::f32x4 (&acc)[2][2][4][2], const pg8::Unit& u, int wr, int wc, int fr, int fq) const {
#pragma unroll
        for (int ai = 0; ai < 2; ++ai)
#pragma unroll
            for (int m = 0; m < 4; ++m) {
                const size_t row = (size_t)u.pm * 256 + 128 * ai + 64 * wr + 16 * m + fr;
#pragma unroll
                for (int bj = 0; bj < 2; ++bj)
#pragma unroll
                    for (int n = 0; n < 2; ++n) {
                        const size_t off = row * DM + u.pn * 256 + 128 * bj + 32 * wc + 16 * n + 4 * fq;
                        const f32x4 r = *(const f32x4*)(src + off);
                        *(f32x4*)(out + off) = r + acc[ai][bj][m][n];
                    }
                asm volatile("" ::: "memory");
            }
    }
};

DI void transpose_item(const float* W, int ldw, const float* gain, bf16_t* WT, int K, int k0, int n0, int nd, LAS float* scr, int lane) {
    f32x4 tw[8]; float gg[8];
#pragma unroll
    for (int i = 0; i < 8; ++i) { const int kk = 8 * i + (lane >> 3); tw[i] = *(const f32x4*)(W + (size_t)(k0 + kk) * ldw + n0 + 4 * (lane & 7)); gg[i] = gain ? gain[k0 + kk] : 1.0f; }
#pragma unroll
    for (int i = 0; i < 8; ++i) { const int kk = 8 * i + (lane >> 3); LAS float* d = scr + kk * 33 + 4 * (lane & 7);
        d[0] = tw[i][0] * gg[i]; d[1] = tw[i][1] * gg[i]; d[2] = tw[i][2] * gg[i]; d[3] = tw[i][3] * gg[i]; }
    asm volatile("s_waitcnt lgkmcnt(0)" ::: "memory");
    const int c = lane & 7;
#pragma unroll
    for (int j = 0; j < 4; ++j) { const int n = (lane >> 3) + 8 * j; const LAS float* s = scr + (8 * c) * 33 + n;
        u32x4 o; o.x = pk2(s[0 * 33], s[1 * 33]); o.y = pk2(s[2 * 33], s[3 * 33]); o.z = pk2(s[4 * 33], s[5 * 33]); o.w = pk2(s[6 * 33], s[7 * 33]);
        *(u32x4*)(WT + (size_t)(nd + n) * K + k0 + 8 * c) = o; }
    asm volatile("s_waitcnt lgkmcnt(0)" ::: "memory");
}

DI void norm_row(const float* xrow, const LAS f32x4* wfl, const float* fbias, bf16_t* orow, float* logf_b  , int s, int lane) {
    asm volatile("" ::: "memory");
    f32x4 v[8]; float ss = 0.f; float fl[8];
#pragma unroll
    for (int h = 0; h < 8; ++h) fl[h] = 0.f;
#pragma unroll
    for (int j = 0; j < 8; ++j) { v[j] = ((const f32x4*)xrow)[lane + 64 * j]; ss += (v[j][0] * v[j][0] + v[j][1] * v[j][1]) + (v[j][2] * v[j][2] + v[j][3] * v[j][3]); }
#pragma unroll
    for (int j = 0; j < 8; ++j) {
#pragma unroll
        for (int e = 0; e < 4; ++e) {
            const float xg = v[j][e];
            const f32x4 w0 = wfl[((j * 4 + e) * 2 + 0) * 64 + lane], w1 = wfl[((j * 4 + e) * 2 + 1) * 64 + lane];
            fl[0] += xg * w0[0]; fl[1] += xg * w0[1]; fl[2] += xg * w0[2]; fl[3] += xg * w0[3];
            fl[4] += xg * w1[0]; fl[5] += xg * w1[1]; fl[6] += xg * w1[2]; fl[7] += xg * w1[3];
        }
    }
    ss = wave_sum(ss);
#pragma unroll
    for (int h = 0; h < 8; ++h) fl[h] = wave_sum(fl[h]);
    const float rstd = rsqrtf(ss * (1.0f / DM) + 1e-6f);
    unsigned long long* o8 = (unsigned long long*)orow + lane;
#pragma unroll
    for (int j = 0; j < 8; ++j) o8[64 * j] = (unsigned long long)pk2(v[j][0] * rstd, v[j][1] * rstd) | ((unsigned long long)pk2(v[j][2] * rstd, v[j][3] * rstd) << 32);
    float mine = fl[0];
#pragma unroll
    for (int h = 1; h < 8; ++h) mine = (lane == h) ? fl[h] : mine;
    if (lane < 8) {
        const float z = mine * rstd + fbias[lane];
        const float lf = fminf(z, 0.f) - log1pf(expf(-fabsf(z)));
        logf_b[(size_t)lane * S + s] = lf;
    }
}

DI int crow(int i, int h) { return (i & 3) + 8 * (i >> 2) + 4 * h; }
DI int kperm(int r) { return (r & ~12) | ((r & 4) << 1) | ((r & 8) >> 1); }
DI int kidx(int i, int h) { return 16 * (i >> 3) + 8 * h + (i & 7); }
DI void load_q(bf16x8 (&qf)[4], const bf16_t* qrow) {
#pragma unroll
    for (int sp = 0; sp < 4; ++sp) qf[sp] = *(const bf16x8*)(qrow + 16 * sp);
}
DI void load_v(bf16x8 (&vf)[2][2], const bf16_t* vb  ) {
#pragma unroll
    for (int dd = 0; dd < 2; ++dd)
#pragma unroll
        for (int s = 0; s < 2; ++s) vf[dd][s] = *(const bf16x8*)(vb + (size_t)dd * 32 * S + 16 * s);
}
DI f32x16 qk_tile(const bf16x8 (&kf)[4], const bf16x8 (&qf)[4]) {
    f32x16 x;
#pragma unroll
    for (int i = 0; i < 16; ++i) x[i] = 0.f;
#pragma unroll
    for (int sp = 0; sp < 4; ++sp) x = mfma32(kf[sp], qf[sp], x);
    return x;
}
DI void pv_tile(f32x16& o0, f32x16& o1, const bf16x8 (&vf)[2][2], const float (&p)[16]) {
    const bf16x8 p0 = pack8((f32x8){p[0], p[1], p[2], p[3], p[4], p[5], p[6], p[7]});
    const bf16x8 p1 = pack8((f32x8){p[8], p[9], p[10], p[11], p[12], p[13], p[14], p[15]});
    o0 = mfma32(vf[0][0], p0, o0); o0 = mfma32(vf[0][1], p1, o0);
    o1 = mfma32(vf[1][0], p0, o1); o1 = mfma32(vf[1][1], p1, o1);
}
DI void store_y(const f32x16& o0, const f32x16& o1, float inv, const bf16_t* G, bf16_t* Y, size_t row, int col0, int h) {
#pragma unroll
    for (int dd = 0; dd < 2; ++dd)
#pragma unroll
        for (int g = 0; g < 4; ++g) {
            const size_t off = row * DM + col0 + 32 * dd + 8 * g + 4 * h;
            const s16x4 gt = *(const s16x4*)(G + off);
            f32x4 t;
#pragma unroll
            for (int e = 0; e < 4; ++e) t[e] = (dd == 0 ? o0[4 * g + e] : o1[4 * g + e]) * inv * bf2f((unsigned short)gt[e]);
            *(s16x4*)(Y + off) = pack4(t);
        }
}

template <int MODE>
DI void attn_item(const bf16_t* Qm, const bf16_t* Km, const bf16_t* Vtm, const float* Fb, const float* KMPb, const bf16_t* G, bf16_t* Y, int bh, int qt, int mixer, float Mb, int lane) {
    asm volatile("" : "+v"(lane));
    const int r = lane & 31, h = lane >> 5;
    const int q0 = qt * 32, t = q0 + r;
    bf16x8 qf[4];
    load_q(qf, Qm + ((size_t)bh * S + t) * 64 + 8 * h);
    const bf16_t* kb = Km + ((size_t)bh * S + kperm(r)) * 64 + 8 * h;
    const bf16_t* vb = Vtm + ((size_t)bh * 64 + r) * S + 8 * h;
    const int qblk = qt >> 3;
    unsigned sel = 0u, vis = 0xffffffffu;
    float ft = 0.f, Ft0 = 0.f;
    if (MODE == 3) { ft = Fb[t]; Ft0 = Fb[q0]; }
    if (MODE == 2) {
        if (qblk > 0) {
            f32x16 gx;
#pragma unroll
            for (int i = 0; i < 16; ++i) gx[i] = 0.f;
#pragma unroll
            for (int sp = 0; sp < 4; ++sp) {
                const float* kp = KMPb + (size_t)(r * 2) * 64 + 16 * sp + 8 * h;
                const f32x4 a0 = *(const f32x4*)kp, a1 = *(const f32x4*)(kp + 4), b0 = *(const f32x4*)(kp + 64), b1 = *(const f32x4*)(kp + 68);
                f32x8 km, hi_f;
#pragma unroll
                for (int e = 0; e < 4; ++e) { km[e] = (a0[e] + b0[e]) * (1.0f / 256.0f); km[4 + e] = (a1[e] + b1[e]) * (1.0f / 256.0f); }
                const bf16x8 hi = pack8(km);
#pragma unroll
                for (int e = 0; e < 8; ++e) hi_f[e] = km[e] - bf2f((unsigned short)hi[e]);
                const bf16x8 lo = pack8(hi_f);
                gx = mfma32(hi, qf[sp], gx); gx = mfma32(lo, qf[sp], gx);
            }
            const float NEGI = -__builtin_inff();
#pragma unroll
            for (int i = 0; i < 16; ++i) if (crow(i, h) >= qblk) gx[i] = NEGI;
#pragma unroll
            for (int it = 0; it < 3; ++it) {
                float bv = NEGI; int bn = 64;
#pragma unroll
                for (int i = 0; i < 16; ++i) if (gx[i] > bv) { bv = gx[i]; bn = crow(i, h); }
                const float pv = shx<32>(bv); const int pn = shxi<32>(bn);
                if (pv > bv || (pv == bv && pn < bn)) { bv = pv; bn = pn; }
                if (bv > NEGI) sel |= 1u << bn;
#pragma unroll
                for (int i = 0; i < 16; ++i) if (crow(i, h) == bn) gx[i] = NEGI;
            }
        }
        vis = sel;
        vis |= (unsigned)shxi<1>((int)vis); vis |= (unsigned)shxi<2>((int)vis); vis |= (unsigned)shxi<4>((int)vis); vis |= (unsigned)shxi<8>((int)vis); vis |= (unsigned)shxi<16>((int)vis); vis |= (unsigned)shxi<32>((int)vis);
        vis |= 1u << qblk;
    }
    f32x16 o0, o1;
#pragma unroll
    for (int i = 0; i < 16; ++i) { o0[i] = 0.f; o1[i] = 0.f; }
    float l = 0.f, R = 0.f;
    const float mb2 = -Mb * LOG2E;

    int tau = qt;
    bf16x8 kfA[4], vfA[2][2]; f32x4 fsA[4];
    load_q(kfA, kb + (size_t)tau * 32 * 64);
    load_v(vfA, vb + tau * 32);
    if (MODE == 3) {
#pragma unroll
        for (int g = 0; g < 4; ++g) fsA[g] = *(const f32x4*)(Fb + tau * 32 + 16 * (g >> 1) + 8 * h + 4 * (g & 1));
    }
    while (tau >= 0) {
        int nxt = tau - 1;
        if (MODE == 2) { while (nxt >= 0 && !((vis >> (nxt >> 3)) & 1u)) nxt = (nxt >> 3) * 8 - 1; }
        if (MODE == 3) { if (nxt >= 0) { const float fk = Fb[nxt * 32 + 31]; if ((Ft0 - fk) + 2.0f * Mb < -104.0f) nxt = -1; } }
        nxt = __builtin_amdgcn_readfirstlane(nxt);
        bf16x8 kfB[4], vfB[2][2]; f32x4 fsB[4];
#pragma unroll
        for (int sp = 0; sp < 4; ++sp) kfB[sp] = kfA[sp];
#pragma unroll
        for (int dd = 0; dd < 2; ++dd) { vfB[dd][0] = vfA[dd][0]; vfB[dd][1] = vfA[dd][1]; }
#pragma unroll
        for (int g = 0; g < 4; ++g) fsB[g] = fsA[g];
        if (nxt >= 0) {
            load_q(kfB, kb + (size_t)nxt * 32 * 64);
            load_v(vfB, vb + nxt * 32);
            if (MODE == 3) {
#pragma unroll
                for (int g = 0; g < 4; ++g) fsB[g] = *(const f32x4*)(Fb + nxt * 32 + 16 * (g >> 1) + 8 * h + 4 * (g & 1));
            }
        }
        const f32x16 x = qk_tile(kfA, qf);
        const bool diag = (tau == qt);
        float p[16];
        if (MODE == 1) {
            float sp_[16];
#pragma unroll
            for (int i = 0; i < 16; ++i) {
                const float z = x[i];
                sp_[i] = fmaxf(z, 0.f) + LN2 * lg2(1.0f + ex2(-fabsf(z) * LOG2E));
            }
            if (diag) {
#pragma unroll
                for (int i = 0; i < 16; ++i) if (!(kidx(i, h) < r)) sp_[i] = 0.f;
            }
            float sfx[16], T[2], bT[2];
#pragma unroll
            for (int o = 0; o < 2; ++o) {
                sfx[8 * o + 7] = sp_[8 * o + 7];
#pragma unroll
                for (int e = 6; e >= 0; --e) sfx[8 * o + e] = sp_[8 * o + e] + sfx[8 * o + e + 1];
                T[o] = sfx[8 * o];
                bT[o] = shx<32>(T[o]);
            }
            float off[2];
            off[1] = R + (h == 0 ? bT[1] : 0.f);
            off[0] = R + (T[1] + bT[1]) + (h == 0 ? bT[0] : 0.f);
            R = R + (T[1] + bT[1]) + (T[0] + bT[0]);
#pragma unroll
            for (int i = 0; i < 16; ++i) {
                const float c = off[i >> 3] + sfx[i];
                p[i] = ex2((x[i] - c) * LOG2E);
            }
            if (diag) {
#pragma unroll
                for (int i = 0; i < 16; ++i) if (!(kidx(i, h) < r)) p[i] = 0.f;
            }
        } else if (MODE == 2) {
            const int nb = tau >> 3;
            const bool own = (nb == qblk);
            const bool lane_ok = own || ((sel >> nb) & 1u);
#pragma unroll
            for (int i = 0; i < 16; ++i) {
                float v = ex2(fmaf(x[i], LOG2E, mb2));
                if (!lane_ok || (diag && kidx(i, h) > r)) v = 0.f;
                p[i] = v; l += v;
            }
        } else {
#pragma unroll
            for (int i = 0; i < 16; ++i) {
                const float dF = ft - fsA[i >> 2][i & 3];
                float v = ex2(fmaf(x[i], LOG2E, (dF - Mb) * LOG2E));
                if (diag && kidx(i, h) > r) v = 0.f;
                p[i] = v; l += v;
            }
        }
        pv_tile(o0, o1, vfA, p);
        if (MODE == 1) { if (__ballot(R < 104.0f) == 0ull) nxt = -1; }
#pragma unroll
        for (int sp = 0; sp < 4; ++sp) kfA[sp] = kfB[sp];
#pragma unroll
        for (int dd = 0; dd < 2; ++dd) { vfA[dd][0] = vfB[dd][0]; vfA[dd][1] = vfB[dd][1]; }
#pragma unroll
        for (int g = 0; g < 4; ++g) fsA[g] = fsB[g];
        tau = nxt;
    }
    float inv = 1.0f;
    if (MODE != 1) { l += shx<32>(l); inv = 1.0f / l; }
    store_y(o0, o1, inv, G, Y, (size_t)(bh >> 3) * S + t, mixer * 512 + (bh & 7) * 64, h);
}

constexpr int AW_K = 0, AW_V = 9216, AW_F = 9216 + 9216, AW_BUF = 9216 + 9216 + 256;
DI unsigned moba_select(const float* KMPb, const bf16x8 (&qf)[4], int qblk, int r, int h) {
    unsigned sel = 0u;
    if (qblk > 0) {
        f32x16 gx;
#pragma unroll
        for (int i = 0; i < 16; ++i) gx[i] = 0.f;
#pragma unroll
        for (int sp = 0; sp < 4; ++sp) {
            const float* kp = KMPb + (size_t)(r * 2) * 64 + 16 * sp + 8 * h;
            const f32x4 a0 = *(const f32x4*)kp, a1 = *(const f32x4*)(kp + 4), b0 = *(const f32x4*)(kp + 64), b1 = *(const f32x4*)(kp + 68);
            f32x8 km, hi_f;
#pragma unroll
            for (int e = 0; e < 4; ++e) { km[e] = (a0[e] + b0[e]) * (1.0f / 256.0f); km[4 + e] = (a1[e] + b1[e]) * (1.0f / 256.0f); }
            const bf16x8 hi = pack8(km);
#pragma unroll
            for (int e = 0; e < 8; ++e) hi_f[e] = km[e] - bf2f((unsigned short)hi[e]);
            const bf16x8 lo = pack8(hi_f);
            gx = mfma32(hi, qf[sp], gx); gx = mfma32(lo, qf[sp], gx);
        }
        const float NEGI = -__builtin_inff();
#pragma unroll
        for (int i = 0; i < 16; ++i) if (crow(i, h) >= qblk) gx[i] = NEGI;
#pragma unroll
        for (int it = 0; it < 3; ++it) {
            float bv = NEGI; int bn = 64;
#pragma unroll
            for (int i = 0; i < 16; ++i) if (gx[i] > bv) { bv = gx[i]; bn = crow(i, h); }
            const float pv = shx<32>(bv); const int pn = shxi<32>(bn);
            if (pv > bv || (pv == bv && pn < bn)) { bv = pv; bn = pn; }
            if (bv > NEGI) sel |= 1u << bn;
#pragma unroll
            for (int i = 0; i < 16; ++i) if (crow(i, h) == bn) gx[i] = NEGI;
        }
    }
    return sel;
}
DI unsigned wave_or(unsigned v) { v |= (unsigned)shxi<1>((int)v); v |= (unsigned)shxi<2>((int)v); v |= (unsigned)shxi<4>((int)v); v |= (unsigned)shxi<8>((int)v); v |= (unsigned)shxi<16>((int)v); v |= (unsigned)shxi<32>((int)v); return v; }

template <int MODE>
DI void sub_tile(const bf16x8 (&kf)[4], const bf16x8 (&vf)[2][2], const bf16x8 (&qf)[4], f32x16& o0, f32x16& o1, float& l, bool diag, float offs, float fm, const LAS float* fsp, int r, int h) {
    f32x16 x;
    float p[16];
    if (MODE == 2) {
#pragma unroll
        for (int i = 0; i < 16; ++i) x[i] = offs;
#pragma unroll
        for (int sp = 0; sp < 4; ++sp) x = mfma32(kf[sp], qf[sp], x);
#pragma unroll
        for (int i = 0; i < 16; ++i) p[i] = ex2(x[i]);
    } else {
        x = qk_tile(kf, qf);
#pragma unroll
        for (int g = 0; g < 4; ++g) {
            const f32x4 fs = *(const LAS f32x4*)(fsp + 16 * (g >> 1) + 8 * h + 4 * (g & 1));
#pragma unroll
            for (int e = 0; e < 4; ++e) p[4 * g + e] = ex2(x[4 * g + e] + (fm - fs[e]));
        }
    }
    if (diag) {
#pragma unroll
        for (int i = 0; i < 16; ++i) if (kidx(i, h) > r) p[i] = 0.f;
    }
#pragma unroll
    for (int i = 0; i < 16; ++i) l += p[i];
    pv_tile(o0, o1, vf, p);
}

template <int MODE>
DI void attn_wg2_item(const bf16_t* Qm, const bf16_t* Km, const bf16_t* Vtm, const float* Fb, const float* KMPb, const bf16_t* G, bf16_t* Y, int bh, int qb2, int halfq, int mixer, float Mb, LAS unsigned char* lds, int tid, int wave, int lane) {
    asm volatile("" : "+v"(tid), "+v"(lane));
    const int r = lane & 31, h = lane >> 5;
    const int qtA = halfq ? qb2 * 8 + wave : qb2 * 16 + wave, qtB = halfq ? -1 : qb2 * 16 + 15 - wave, tA = qtA * 32 + r, tB = halfq ? tA : qtB * 32 + r;
    bf16x8 qfA[4], qfB[4];
    load_q(qfA, Qm + ((size_t)bh * S + tA) * 64 + 8 * h);
    load_q(qfB, Qm + ((size_t)bh * S + tB) * 64 + 8 * h);
    const int qblkA = qtA >> 3, qblkB = halfq ? 0 : (qtB >> 3);
    unsigned selA = 0u, selB = 0u, visA = 0xffffffffu, visB = 0xffffffffu;
    float fmA = 0.f, fmB = 0.f, Ft0 = 0.f;
    if (MODE == 3) { fmA = (Fb[tA] - Mb) * LOG2E; fmB = (Fb[tB] - Mb) * LOG2E; Ft0 = Fb[halfq ? qb2 * 256 : qb2 * 512]; }
    if (MODE == 2) {
        selA = moba_select(KMPb, qfA, qblkA, r, h); selB = halfq ? 0u : moba_select(KMPb, qfB, qblkB, r, h);
        visA = wave_or(selA) | (1u << qblkA); visB = wave_or(selB) | (1u << qblkB);
    }
    f32x16 oA0, oA1, oB0, oB1;
#pragma unroll
    for (int i = 0; i < 16; ++i) { oA0[i] = 0.f; oA1[i] = 0.f; oB0[i] = 0.f; oB1[i] = 0.f; }
    float lA = 0.f, lB = 0.f;
    const float mb2 = -Mb * LOG2E, NEGI = -__builtin_inff();
    const int srow = tid >> 3, sch = tid & 7;
    const bf16_t* kg = Km + ((size_t)bh * S + srow) * 64 + sch * 8;
    const bf16_t* vg = Vtm + ((size_t)bh * 64 + srow) * S + sch * 8;
    const unsigned kws = AW_K + srow * 144 + sch * 16, vws = AW_V + srow * 144 + sch * 16;
    const unsigned kra = AW_K + kperm(r) * 144 + 16 * h, vra = AW_V + r * 144 + 16 * h;
    int cur = halfq ? qb2 * 4 + 3 : qb2 * 8 + 7, buf = 0;
    {
        const bf16x8 kreg = *(const bf16x8*)(kg + (size_t)cur * 4096);
        const u32x4 vreg = *(const u32x4*)(vg + cur * 64);
        *(LAS bf16x8*)(lds + kws) = kreg;
        *(LAS u32x4*)(lds + vws) = vreg;
        if (MODE == 3 && tid < 16) *(LAS f32x4*)(lds + AW_F + tid * 16) = *(const f32x4*)(Fb + cur * 64 + tid * 4) * LOG2E;
    }
    __syncthreads();
    while (cur >= 0) {
        int nxt = cur - 1;
        if (MODE == 3) { if (nxt >= 0) { const float fk = Fb[nxt * 64 + 63]; if ((Ft0 - fk) + 2.0f * Mb < -104.0f) nxt = -1; } }
        nxt = __builtin_amdgcn_readfirstlane(nxt);
        bf16x8 kreg; u32x4 vreg; f32x4 freg;
#pragma unroll
        for (int e = 0; e < 8; ++e) kreg[e] = 0;
        vreg = (u32x4){0u, 0u, 0u, 0u}; freg = (f32x4){0.f, 0.f, 0.f, 0.f};
        if (nxt >= 0) {
            kreg = *(const bf16x8*)(kg + (size_t)nxt * 4096);
            vreg = *(const u32x4*)(vg + nxt * 64);
            if (MODE == 3 && tid < 16) freg = *(const f32x4*)(Fb + nxt * 64 + tid * 4);
        }
        LAS unsigned char* lb = lds + buf * AW_BUF;
#pragma unroll
        for (int kk = 1; kk >= 0; --kk) {
            const int tau = cur * 2 + kk, nb = tau >> 3;
            bool actA = tau <= qtA, actB = tau <= qtB;
            if (MODE == 2) { actA = actA && ((visA >> nb) & 1u); actB = actB && ((visB >> nb) & 1u); }
            if (actA || actB) {
                bf16x8 kf[4], vf[2][2];
#pragma unroll
                for (int sp = 0; sp < 4; ++sp) kf[sp] = *(LAS bf16x8*)(lb + kra + kk * 32 * 144 + sp * 32);
#pragma unroll
                for (int dd = 0; dd < 2; ++dd)
#pragma unroll
                    for (int s = 0; s < 2; ++s) vf[dd][s] = *(LAS bf16x8*)(lb + vra + dd * 32 * 144 + kk * 64 + s * 32);
                float offA = mb2, offB = mb2;
                if (MODE == 2) { offA = ((nb == qblkA) || ((selA >> nb) & 1u)) ? mb2 : NEGI; offB = ((nb == qblkB) || ((selB >> nb) & 1u)) ? mb2 : NEGI; }
                const LAS float* fsp = (const LAS float*)(lb + AW_F) + kk * 32;
                if (actA) sub_tile<MODE>(kf, vf, qfA, oA0, oA1, lA, tau == qtA, offA, fmA, fsp, r, h);
                if (actB) sub_tile<MODE>(kf, vf, qfB, oB0, oB1, lB, tau == qtB, offB, fmB, fsp, r, h);
            }
        }
        if (nxt >= 0) {
            LAS unsigned char* nb_ = lds + (buf ^ 1) * AW_BUF;
            *(LAS bf16x8*)(nb_ + kws) = kreg;
            *(LAS u32x4*)(nb_ + vws) = vreg;
            if (MODE == 3 && tid < 16) *(LAS f32x4*)(nb_ + AW_F + tid * 16) = freg * LOG2E;
        }
        __syncthreads();
        buf ^= 1; cur = nxt;
    }
    lA += shx<32>(lA); lB += shx<32>(lB);
    store_y(oA0, oA1, 1.0f / lA, G, Y, (size_t)(bh >> 3) * S + tA, mixer * 512 + (bh & 7) * 64, h);
    if (!halfq) store_y(oB0, oB1, 1.0f / lB, G, Y, (size_t)(bh >> 3) * S + tB, mixer * 512 + (bh & 7) * 64, h);
}

DI void sub_tile_sb(const bf16x8 (&kf)[4], const bf16x8 (&vf)[2][2], const bf16x8 (&qf)[4], f32x16& o0, f32x16& o1, float& R, bool diag, int r, int h) {
    const f32x16 x = qk_tile(kf, qf);
    float sp_[16], p[16];
#pragma unroll
    for (int e = 0; e < 16; ++e) { const float z = x[e]; sp_[e] = fmaxf(z, 0.f) + LN2 * lg2(1.0f + ex2(-fabsf(z) * LOG2E)); }
    if (diag) {
#pragma unroll
        for (int e = 0; e < 16; ++e) if (!(kidx(e, h) < r)) sp_[e] = 0.f;
    }
    float sfx[16], T[2], bT[2];
#pragma unroll
    for (int o = 0; o < 2; ++o) {
        sfx[8 * o + 7] = sp_[8 * o + 7];
#pragma unroll
        for (int e = 6; e >= 0; --e) sfx[8 * o + e] = sp_[8 * o + e] + sfx[8 * o + e + 1];
        T[o] = sfx[8 * o];
        bT[o] = shx<32>(T[o]);
    }
    float off[2];
    off[1] = R + (h == 0 ? bT[1] : 0.f);
    off[0] = R + (T[1] + bT[1]) + (h == 0 ? bT[0] : 0.f);
    R = R + (T[1] + bT[1]) + (T[0] + bT[0]);
#pragma unroll
    for (int e = 0; e < 16; ++e) p[e] = ex2((x[e] - (off[e >> 3] + sfx[e])) * LOG2E);
    if (diag) {
#pragma unroll
        for (int e = 0; e < 16; ++e) if (!(kidx(e, h) < r)) p[e] = 0.f;
    }
    pv_tile(o0, o1, vf, p);
}
DI void attn_wgB_item(const bf16_t* Qm, const bf16_t* Km, const bf16_t* Vtm, const bf16_t* G, bf16_t* Y, int bh, int qb2, int halfq, LAS unsigned char* lds, int tid, int wave, int lane) {
    asm volatile("" : "+v"(tid), "+v"(lane));
    const int r = lane & 31, h = lane >> 5;
    const int qtA = halfq ? qb2 * 8 + wave : qb2 * 16 + wave, qtB = halfq ? -1 : qb2 * 16 + 15 - wave, tA = qtA * 32 + r, tB = halfq ? tA : qtB * 32 + r;
    bf16x8 qfA[4], qfB[4];
    load_q(qfA, Qm + ((size_t)bh * S + tA) * 64 + 8 * h);
    load_q(qfB, Qm + ((size_t)bh * S + tB) * 64 + 8 * h);
    f32x16 oA0, oA1, oB0, oB1;
#pragma unroll
    for (int i = 0; i < 16; ++i) { oA0[i] = 0.f; oA1[i] = 0.f; oB0[i] = 0.f; oB1[i] = 0.f; }
    float RA = 0.f, RB = 0.f;
    bool doneA = false, doneB = (halfq != 0);
    const int srow = tid >> 3, sch = tid & 7;
    const bf16_t* kg = Km + ((size_t)bh * S + srow) * 64 + sch * 8;
    const bf16_t* vg = Vtm + ((size_t)bh * 64 + srow) * S + sch * 8;
    const unsigned kws = AW_K + srow * 144 + sch * 16, vws = AW_V + srow * 144 + sch * 16;
    const unsigned kra = AW_K + kperm(r) * 144 + 16 * h, vra = AW_V + r * 144 + 16 * h;
    LAS int* fl = (LAS int*)(lds + 2 * AW_BUF);
    int cur = halfq ? qb2 * 4 + 3 : qb2 * 8 + 7, buf = 0, it = 0;
    {
        const bf16x8 kreg = *(const bf16x8*)(kg + (size_t)cur * 4096);
        const u32x4 vreg = *(const u32x4*)(vg + cur * 64);
        *(LAS bf16x8*)(lds + kws) = kreg;
        *(LAS u32x4*)(lds + vws) = vreg;
    }
    __syncthreads();
    while (cur >= 0) {
        int nxt = cur - 1;
        bf16x8 kreg; u32x4 vreg;
#pragma unroll
        for (int e = 0; e < 8; ++e) kreg[e] = 0;
        vreg = (u32x4){0u, 0u, 0u, 0u};
        if (nxt >= 0) {
            kreg = *(const bf16x8*)(kg + (size_t)nxt * 4096);
            vreg = *(const u32x4*)(vg + nxt * 64);
        }
        LAS unsigned char* lb = lds + buf * AW_BUF;
#pragma unroll
        for (int kk = 1; kk >= 0; --kk) {
            const int tau = cur * 2 + kk;
            const bool actA = (tau <= qtA) && !doneA, actB = (tau <= qtB) && !doneB;
            if (actA || actB) {
                bf16x8 kf[4], vf[2][2];
#pragma unroll
                for (int sp = 0; sp < 4; ++sp) kf[sp] = *(LAS bf16x8*)(lb + kra + kk * 32 * 144 + sp * 32);
#pragma unroll
                for (int dd = 0; dd < 2; ++dd)
#pragma unroll
                    for (int s = 0; s < 2; ++s) vf[dd][s] = *(LAS bf16x8*)(lb + vra + dd * 32 * 144 + kk * 64 + s * 32);
                if (actA) { sub_tile_sb(kf, vf, qfA, oA0, oA1, RA, tau == qtA, r, h); if (__ballot(RA < 104.0f) == 0ull) doneA = true; }
                if (actB) { sub_tile_sb(kf, vf, qfB, oB0, oB1, RB, tau == qtB, r, h); if (__ballot(RB < 104.0f) == 0ull) doneB = true; }
            }
        }
        if (nxt >= 0) {
            LAS unsigned char* nb_ = lds + (buf ^ 1) * AW_BUF;
            *(LAS bf16x8*)(nb_ + kws) = kreg;
            *(LAS u32x4*)(nb_ + vws) = vreg;
        }
        if (lane == 0) fl[(it & 1) * 8 + wave] = (doneA && doneB) ? 1 : 0;
        __syncthreads();
        int all = 1;
#pragma unroll
        for (int w = 0; w < 8; ++w) all &= fl[(it & 1) * 8 + w];
        if (__builtin_amdgcn_readfirstlane(all)) nxt = -1;
        buf ^= 1; cur = nxt; ++it;
    }
    store_y(oA0, oA1, 1.0f, G, Y, (size_t)(bh >> 3) * S + tA, 1 * 512 + (bh & 7) * 64, h);
    if (!halfq) store_y(oB0, oB1, 1.0f, G, Y, (size_t)(bh >> 3) * S + tB, 1 * 512 + (bh & 7) * 64, h);
}

DI void attn_A_item(const bf16_t* Q0, const bf16_t* K0, const bf16_t* VT0, const bf16_t* VTXp, const bf16_t* G, bf16_t* Y, int bh, int blk, float Mb, LAS float* Oacc, LAS float* lacc, int tid, int wave, int lane) {
    asm volatile("" : "+v"(tid), "+v"(lane));
    const int r = lane & 31, h = lane >> 5, t0 = blk * 512;
    {
        LAS f32x4* row = (LAS f32x4*)(Oacc + tid * 68);
#pragma unroll
        for (int i = 0; i < 17; ++i) row[i] = (f32x4){0.f, 0.f, 0.f, 0.f};
        lacc[tid] = 0.f;
    }
    __syncthreads();
    const float mb2 = -Mb * LOG2E;
#pragma unroll 1
    for (int seg = 0; seg < 3; ++seg) {
        const int sh = 2 * seg, L = S >> sh;
        const bf16_t* Vs = (seg == 0) ? (VT0 + (size_t)bh * 64 * S) : (VTXp + (size_t)((seg - 1) * 16 + bh) * 64 * S);
#pragma unroll 1
        for (int jq = 0; jq < 2; ++jq) {
            const int j = 2 * wave + jq, tpr = 16 >> sh, res = j / tpr, jj = j % tpr, m0 = (t0 >> sh) + 32 * jj;
            const int t = ((m0 + r) << sh) + res;
            bf16x8 qf[4];
            load_q(qf, Q0 + ((size_t)bh * S + t) * 64 + 8 * h);
            f32x16 o0, o1;
#pragma unroll
            for (int i = 0; i < 16; ++i) { o0[i] = 0.f; o1[i] = 0.f; }
            float l = 0.f;
            const int kfirst = m0 - 128;
            const float NEGI = -__builtin_inff();
            bf16x8 kf[5][4];
#pragma unroll
            for (int i = 0; i < 5; ++i) {
                const int kt = kfirst + 32 * i, ktc = kt < 0 ? 0 : kt;
                load_q(kf[i], K0 + ((size_t)bh * S + (((ktc + kperm(r)) << sh) + res)) * 64 + 8 * h);
            }
            f32x16 xs[5];
#pragma unroll
            for (int i = 0; i < 5; ++i) {
                const float offs = (kfirst + 32 * i < 0) ? NEGI : mb2;
#pragma unroll
                for (int e = 0; e < 16; ++e) xs[i][e] = offs;
#pragma unroll
                for (int sp = 0; sp < 4; ++sp) xs[i] = mfma32(kf[i][sp], qf[sp], xs[i]);
            }
#pragma unroll
            for (int i = 0; i < 5; ++i) {
                const int kt = kfirst + 32 * i, ktc = kt < 0 ? 0 : kt;
                bf16x8 vf[2][2];
                load_v(vf, Vs + (size_t)r * S + (size_t)res * L + ktc + 8 * h);
                float p[16];
#pragma unroll
                for (int e = 0; e < 16; ++e) {
                    float v = ex2(xs[i][e]);
                    const int c = kidx(e, h);
                    if ((i == 0 && c < r) || (i == 4 && c > r)) v = 0.f;
                    p[e] = v;
                }
#pragma unroll
                for (int e = 0; e < 16; ++e) l += p[e];
                pv_tile(o0, o1, vf, p);
            }
            l += shx<32>(l);
            const int tl = t - t0;
#pragma unroll
            for (int dd = 0; dd < 2; ++dd)
#pragma unroll
                for (int g = 0; g < 4; ++g) {
                    LAS f32x4* pp = (LAS f32x4*)(Oacc + tl * 68 + 32 * dd + 8 * g + 4 * h);
                    f32x4 cur = *pp;
#pragma unroll
                    for (int e = 0; e < 4; ++e) cur[e] += (dd == 0 ? o0[4 * g + e] : o1[4 * g + e]);
                    *pp = cur;
                }
            if (h == 0) lacc[tl] += l;
        }
        __syncthreads();
    }
    {
        const int t = t0 + tid; const size_t row = (size_t)(bh >> 3) * S + t; const int col0 = (bh & 7) * 64;
        const float inv = 1.0f / lacc[tid];
#pragma unroll
        for (int c8 = 0; c8 < 8; ++c8) {
            const f32x4 a0 = *(LAS f32x4*)(Oacc + tid * 68 + 8 * c8), a1 = *(LAS f32x4*)(Oacc + tid * 68 + 8 * c8 + 4);
            const bf16x8 gt = *(const bf16x8*)(G + row * DM + col0 + 8 * c8);
            f32x8 o;
#pragma unroll
            for (int e = 0; e < 4; ++e) { o[e] = a0[e] * inv * bf2f((unsigned short)gt[e]); o[4 + e] = a1[e] * inv * bf2f((unsigned short)gt[4 + e]); }
            *(bf16x8*)(Y + row * DM + col0 + 8 * c8) = pack8(o);
        }
    }
    __syncthreads();
}

#define XB_TMO      128
#define XB_XCNT(j)  (256  + 64 * (j))
#define XB_XSUB(j)  (1280 + 64 * (j))
#define XB_XGEN(j)  (2304 + 64 * (j))
#define XB_TOP      3328
#define XB_TOPGEN   3392
#define XCD_BAR_WORDS 3456
#define XB_SPIN_CAP (1u << 18)

__device__ __forceinline__ unsigned xb_ld(unsigned* p)              { return __hip_atomic_load(p, __ATOMIC_RELAXED, __HIP_MEMORY_SCOPE_AGENT); }
__device__ __forceinline__ unsigned xb_add(unsigned* p, unsigned v) { return __hip_atomic_fetch_add(p, v, __ATOMIC_RELAXED, __HIP_MEMORY_SCOPE_AGENT); }
__device__ __forceinline__ unsigned xb_xcc_id() { return (unsigned)__builtin_amdgcn_s_getreg((3 << 11) | 20) & 0xFu; }
#define XB_SPIN(cond, bar) do { unsigned _sp = 0; while (cond) { __builtin_amdgcn_s_sleep(1); \
    if ((++_sp & 255u) == 0u) { if (xb_ld(&(bar)[XB_TMO])) break; if (_sp > XB_SPIN_CAP) { atomicAdd(&(bar)[XB_TMO], 1u); break; } } } } while (0)

struct XcdBarrier {
    unsigned* bar; unsigned x;
    volatile LAS unsigned* st;
};

__device__ __forceinline__ XcdBarrier xcd_barrier_post(unsigned* bar, volatile LAS unsigned* st) {
    XcdBarrier b; b.bar = bar; b.x = xb_xcc_id(); b.st = st;
    if (threadIdx.x == 0) (void)xb_add(&bar[XB_XCNT(b.x)], 1u);
    return b;
}
__device__ __forceinline__ void xcd_barrier_complete(unsigned* bar, unsigned x, unsigned& nloc, unsigned& nx) {
    const unsigned G = gridDim.x * gridDim.y * gridDim.z;
    unsigned sum, cnt, mine, sp = 0u;
    for (;;) {
        sum = 0u; cnt = 0u; mine = 0u;
#pragma unroll
        for (unsigned j = 0; j < 16; ++j) { const unsigned c = xb_ld(&bar[XB_XCNT(j)]); sum += c; cnt += (c > 0u) ? 1u : 0u; mine = (j == x) ? c : mine; }
        if (sum == G) break;
        __builtin_amdgcn_s_sleep(1);
        if ((++sp & 255u) == 0u) { if (xb_ld(&bar[XB_TMO])) break; if (sp > XB_SPIN_CAP) { atomicAdd(&bar[XB_TMO], 1u); break; } }
    }
    nloc = mine > 0u ? mine : 1u; nx = cnt > 0u ? cnt : 1u;
}

__device__ __forceinline__ void xcd_barrier(const XcdBarrier& b) {
    asm volatile("s_waitcnt vmcnt(0)" ::: "memory");
    __syncthreads();
    if (threadIdx.x == 0) {
        unsigned* bar = b.bar;
        __builtin_amdgcn_s_waitcnt(0);
        unsigned nloc = b.st[0], nx = b.st[1];
        if (nloc == 0u) { xcd_barrier_complete(bar, b.x, nloc, nx); b.st[0] = nloc; b.st[1] = nx; }
        const unsigned old = xb_add(&bar[XB_XSUB(b.x)], 1u);
        const unsigned gen = old / nloc;
        if (old + 1u == (gen + 1u) * nloc) {
            __builtin_amdgcn_fence(__ATOMIC_RELEASE, "agent");
            asm volatile("s_waitcnt vmcnt(0)" ::: "memory");
            const unsigned og = xb_add(&bar[XB_TOP], 1u);
            const unsigned tg = og / nx;
            if (og + 1u == (tg + 1u) * nx) xb_add(&bar[XB_TOPGEN], 1u);
            else XB_SPIN(xb_ld(&bar[XB_TOPGEN]) == tg, bar);
            __builtin_amdgcn_fence(__ATOMIC_ACQUIRE, "agent");
            xb_add(&bar[XB_XGEN(b.x)], 1u);
            asm volatile("s_waitcnt vmcnt(0)" ::: "memory");
        } else {
            XB_SPIN(xb_ld(&bar[XB_XGEN(b.x)]) == gen, bar);
            __builtin_amdgcn_fence(__ATOMIC_ACQUIRE, "agent");
            asm volatile("s_waitcnt vmcnt(0)" ::: "memory");
        }
    }
    __syncthreads();
}

#ifndef REP_A
#define REP_A 1
#endif
#ifndef REP_CD
#define REP_CD 1
#endif
#ifndef REP_B
#define REP_B 1
#endif
#ifndef REP_G1
#define REP_G1 1
#endif
#ifndef REP_G2
#define REP_G2 1
#endif
#ifndef REP_N
#define REP_N 1
#endif
#ifndef REP_P
#define REP_P 1
#endif
__global__ void __launch_bounds__(512, 2) mega_fwd(Args a) {
    extern __shared__ __attribute__((aligned(16))) unsigned char lds_raw[];
    LAS unsigned char* lds = (LAS unsigned char*)lds_raw;
    cg::grid_group grid = cg::this_grid();
    if (threadIdx.x == 0) { ((volatile LAS unsigned*)(lds + 147300))[0] = 0u; ((volatile LAS unsigned*)(lds + 147300))[1] = 0u; }
    __syncthreads();
    (void)xcd_barrier_post((unsigned*)(a.ws + WS_CTL) + 12288, (volatile LAS unsigned*)(lds + 147300));
#define GSYNC() do { const __attribute__((address_space(4))) Args* ap2 = (const __attribute__((address_space(4))) Args*)__builtin_amdgcn_kernarg_segment_ptr(); asm volatile("" : "+s"(ap2)); \
        XcdBarrier xb_; xb_.bar = (unsigned*)(ap2->ws + WS_CTL) + 12288; xb_.x = xb_xcc_id(); xb_.st = (volatile LAS unsigned*)(lds + 147300); xcd_barrier(xb_); } while (0)
#define WSP(T, off) ((T*)(ws + (off)))
#define OPAQUE_WS const __attribute__((address_space(4))) Args* ap = (const __attribute__((address_space(4))) Args*)__builtin_amdgcn_kernarg_segment_ptr(); asm volatile("" : "+s"(ap)); unsigned char* ws = ap->ws; int tid = threadIdx.x; asm volatile("" : "+v"(tid)); const int lane = tid & 63, wave = __builtin_amdgcn_readfirstlane(tid >> 6); int G = gridDim.x; asm volatile("" : "+s"(G)); const int gw = blockIdx.x * 8 + wave, NGW = G * 8; (void)lane; (void)wave; (void)gw; (void)NGW
    {
        OPAQUE_WS;
        bf16_t* WinT = WSP(bf16_t, WS_WIN); bf16_t* WoutT = WSP(bf16_t, WS_WOUT); float* COS = WSP(float, WS_COS); float* SIN = WSP(float, WS_SIN);
        LAS float* scr = (LAS float*)(lds + wave * 16384);
        constexpr int I_IN = 32 * 256, I_OUT = 32 * 64, I_L = I_IN + I_OUT;
        for (int rep = 0; rep < REP_P; ++rep)
        for (int it = gw; it < NL * I_L; it += NGW) {
            const int l = it / I_L; int rr = it % I_L;
            if (rr < I_IN) {
                const int kbk = rr >> 8, nbk = rr & 255, n0 = 32 * nbk;
                const int pns = n0 >> 8, mxs = (pns & 7) >> 1, pnd = (pns & ~7) | ((((mxs & 1) << 1) | (mxs >> 1)) << 1) | (pns & 1);
                const int nd = pnd * 256 + 128 * ((n0 >> 5) & 1) + 32 * ((n0 >> 6) & 3);
                transpose_item(ap->w_in + (size_t)l * DM * NCOL, NCOL, ap->ng + l * DM, WinT + (size_t)l * NPROJ * DM, DM, 64 * kbk, n0, nd, scr, lane);
            } else {
                rr -= I_IN; const int kbk = rr >> 6, nbk = rr & 63;
                transpose_item(ap->w_out + (size_t)l * DM * DM, DM, nullptr, WoutT + (size_t)l * DM * DM, DM, 64 * kbk, 32 * nbk, 32 * nbk, scr, lane);
            }
        }
        {
            float* WF = WSP(float, WS_WF);
            for (int e = blockIdx.x * 512 + tid; e < NL * 4096; e += G * 512) {
                const int l = e >> 12, q = e & 4095, ln = q & 63, hh = (q >> 6) & 1, je = q >> 7, d = 256 * (je >> 2) + 4 * ln + (je & 3);
                const float g = ap->ng[l * DM + d];
                const f32x4 w = *(const f32x4*)(ap->w_in + (size_t)l * DM * NCOL + (size_t)d * NCOL + NPROJ + 4 * hh);
                ((f32x4*)WF)[e] = w * g;
            }
        }
        for (int e = blockIdx.x * 512 + tid; e < S * 32; e += G * 512) {
            const int pos = e >> 5, j = e & 31;
            const float ang = (float)pos * ap->inv_freq[j];
            const double rev = (double)ang * 0.15915494309189535;
            const float fr = (float)(rev - floor(rev));
            COS[e] = __builtin_amdgcn_cosf(fr); SIN[e] = __builtin_amdgcn_sinf(fr);
        }
    }

#pragma unroll 1
    for (int l = 0; l < NL; ++l) {
        {
            OPAQUE_WS;
            bf16_t* XB = WSP(bf16_t, WS_XB); float* LOGF = WSP(float, WS_LOGF);
            const float* src = (l == 0) ? ap->x : ap->out;
            if (l == 0) grid.sync();
            {
                const f32x4* WFg = (const f32x4*)WSP(float, WS_WF) + (size_t)l * 4096;
                LAS f32x4* wfl = (LAS f32x4*)lds;
#pragma unroll
                for (int i = 0; i < 8; ++i) wfl[tid + 512 * i] = WFg[tid + 512 * i];
                __syncthreads();
            }
            for (int rep = 0; rep < REP_N; ++rep)
            for (int m = gw; m < MT; m += NGW) {
                const int b = m / S, s = m % S;
                norm_row(src + (size_t)m * DM, (const LAS f32x4*)lds, ap->fb + l * 8, XB + (size_t)m * DM, LOGF + (size_t)b * 8 * S, s, lane);
            }
        }
        GSYNC();
        if (blockIdx.x < 16) {
            OPAQUE_WS;
            float* LOGF = WSP(float, WS_LOGF); float* FB = WSP(float, WS_F);
            const int bh = blockIdx.x;
            const float* lf = LOGF + (size_t)bh * S + tid * 16;
            float v[16];
#pragma unroll
            for (int i = 0; i < 4; ++i) { const f32x4 t = ((const f32x4*)lf)[i]; v[4 * i] = t[0]; v[4 * i + 1] = t[1]; v[4 * i + 2] = t[2]; v[4 * i + 3] = t[3]; }
            double tot = 0.0;
#pragma unroll
            for (int i = 0; i < 16; ++i) tot += (double)v[i];
            double inc = tot;
#pragma unroll
            for (int o = 1; o < 64; o <<= 1) { const double t = __shfl_up(inc, o); if (lane >= o) inc += t; }
            LAS double* wt = (LAS double*)lds;
            if (lane == 63) wt[wave] = inc;
            __syncthreads();
            double base = inc - tot;
            for (int w = 0; w < wave; ++w) base += wt[w];
            float* fo = FB + (size_t)bh * S + tid * 16;
            double run = base;
#pragma unroll
            for (int i = 0; i < 4; ++i) { f32x4 t; for (int e = 0; e < 4; ++e) { run += (double)v[4 * i + e]; t[e] = (float)run; } ((f32x4*)fo)[i] = t; }
            __syncthreads();
        }
        {
            OPAQUE_WS;
            bf16_t* WinT = WSP(bf16_t, WS_WIN); bf16_t* XB = WSP(bf16_t, WS_XB); bf16_t* Qb = WSP(bf16_t, WS_Q); bf16_t* Kb = WSP(bf16_t, WS_K); bf16_t* VT = WSP(bf16_t, WS_VT); bf16_t* VTX = WSP(bf16_t, WS_VTX);
            bf16_t* Gb = WSP(bf16_t, WS_G); float* KMP = WSP(float, WS_KMP); float* COS = WSP(float, WS_COS); float* SIN = WSP(float, WS_SIN);
            pg8::Gemm g{XB, WinT + (size_t)l * NPROJ * DM, MT, NPROJ, DM}; pg8::StaticOrder So; So.init(MT, NPROJ, G, (int)blockIdx.x);
            EpiIn E{Qb, Kb, VT, VTX, Gb, KMP, ap->qg + l * 192, ap->kg + l * 192, COS, SIN};
            for (int rep = 0; rep < REP_G1; ++rep) pg8::gemm_phase<EpiIn, pg8::StaticOrder, true, true>(lds, g, So, E);
        }
        GSYNC();
        {
            OPAQUE_WS;
            unsigned* ctl = WSP(unsigned, WS_CTL); bf16_t* Qb = WSP(bf16_t, WS_Q); bf16_t* Kb = WSP(bf16_t, WS_K); bf16_t* VT = WSP(bf16_t, WS_VT); bf16_t* VTX = WSP(bf16_t, WS_VTX);
            bf16_t* Gb = WSP(bf16_t, WS_G); bf16_t* Yb = WSP(bf16_t, WS_Y); float* FB = WSP(float, WS_F); float* KMP = WSP(float, WS_KMP);
            float Mx[3];
#pragma unroll
            for (int gi = 0; gi < 3; ++gi) {
                const float gq = wave_max(fabsf(ap->qg[l * 192 + gi * 64 + lane])), gk = wave_max(fabsf(ap->kg[l * 192 + gi * 64 + lane]));
                Mx[gi] = 8.1f * gq * gk;
            }
            LAS float* Oacc = (LAS float*)lds; LAS float* lacc = (LAS float*)(lds + 512 * 68 * 4);
            const int xcc = (int)(__builtin_amdgcn_s_getreg((3 << 11) | 20) & 7u);
            const int vb = (G == 256) ? ((int)(blockIdx.x & 7) * 32 + (int)(blockIdx.x >> 3)) : (int)blockIdx.x;
            for (int rep = 0; rep < REP_A; ++rep)
            for (int it = vb; it < 256; it += G)
                attn_A_item(Qb, Kb, VT, VTX, Gb, Yb, it >> 4, it & 15, Mx[0], Oacc, lacc, tid, wave, lane);
            for (int rep = 0; rep < REP_CD; ++rep) {
                LAS int* qw = (LAS int*)(lds + 147200);
                for (int sq = 0; sq < 8; ++sq) {
                    const int q = (xcc + sq) & 7;
                    unsigned* ctr = ctl + 64 * (l * 16 + q) + 1024 * 4 * rep;
                    for (;;) {
                        if (tid == 0) *qw = (int)atomicAdd(ctr, 1u);
                        __syncthreads();
                        const int idx = __builtin_amdgcn_readfirstlane(*qw);
                        __syncthreads();
                        if (idx >= 72) break;
                        const int k = idx >> 2, j = idx & 3, bh = 2 * q + (j >> 1), halfq = (k >= 6 && k < 10), qb2 = k < 6 ? 13 - k : (halfq ? 37 - k : 17 - k);
                        if (j & 1) attn_wg2_item<3>(Qb + (size_t)3 * 16 * S * 64, Kb + (size_t)3 * 16 * S * 64, VT + (size_t)3 * 16 * 64 * S, FB + (size_t)bh * S, nullptr, Gb, Yb, bh, qb2, halfq, 3, Mx[2], lds, tid, wave, lane);
                        else attn_wg2_item<2>(Qb + (size_t)2 * 16 * S * 64, Kb + (size_t)2 * 16 * S * 64, VT + (size_t)2 * 16 * 64 * S, nullptr, KMP + (size_t)bh * 32 * 2 * 64, Gb, Yb, bh, qb2, halfq, 2, Mx[1], lds, tid, wave, lane);
                    }
                }
            }
            for (int rep = 0; rep < REP_B; ++rep) {
                LAS int* qw = (LAS int*)(lds + 147200);
                for (int sq = 0; sq < 8; ++sq) {
                    const int q = (xcc + sq) & 7;
                    unsigned* ctr = ctl + 64 * (l * 16 + 8 + q) + 1024 * 4 * rep;
                    for (;;) {
                        if (tid == 0) *qw = (int)atomicAdd(ctr, 1u);
                        __syncthreads();
                        const int idx = __builtin_amdgcn_readfirstlane(*qw);
                        __syncthreads();
                        if (idx >= 64) break;
                        const int qb = 31 - (idx >> 1), bh = 2 * q + (idx & 1);
                        attn_wgB_item(Qb + (size_t)1 * 16 * S * 64, Kb + (size_t)1 * 16 * S * 64, VT + (size_t)1 * 16 * 64 * S, Gb, Yb, bh, qb, 1, lds, tid, wave, lane);
                    }
                }
            }
        }
        GSYNC();
        {
            OPAQUE_WS;
            bf16_t* WoutT = WSP(bf16_t, WS_WOUT); bf16_t* Yb = WSP(bf16_t, WS_Y);
            pg8::Gemm g{Yb, WoutT + (size_t)l * DM * DM, MT, DM, DM}; pg8::StaticOrder So; So.init(MT, DM, G, (int)blockIdx.x);
            EpiOut E{(l == 0) ? ap->x : ap->out, ap->out};
            for (int rep = 0; rep < (REP_G2 > 1 && l == 0 ? REP_G2 : 1); ++rep) pg8::gemm_phase<EpiOut, pg8::StaticOrder, true, true>(lds, g, So, E);
        }
        if (l + 1 < NL) GSYNC();
    }
}

extern "C" void kernel_launch(void* const* d_in, const int* in_sizes, int n_in, void* d_out, int out_size, void* d_ws, size_t ws_size, hipStream_t stream) {
    static int grid = 0;
    if (grid == 0) {
        if (n_in != 7 || out_size != MT * DM || ws_size < WS_END) { fprintf(stderr, "kernel_launch: unexpected shapes (n_in %d out %d ws %zu)\n", n_in, out_size, ws_size); grid = -1; return; }
        int dev = 0, cus = 0, per_cu = 0;
        hipGetDevice(&dev); hipDeviceGetAttribute(&cus, hipDeviceAttributeMultiprocessorCount, dev);
        if (hipFuncSetAttribute((const void*)mega_fwd, hipFuncAttributeMaxDynamicSharedMemorySize, LDS_BYTES) != hipSuccess) { fprintf(stderr, "kernel_launch: hipFuncSetAttribute failed\n"); grid = -1; return; }
        if (hipOccupancyMaxActiveBlocksPerMultiprocessor(&per_cu, (const void*)mega_fwd, 512, LDS_BYTES) != hipSuccess || per_cu < 1) { fprintf(stderr, "kernel_launch: occupancy query says %d\n", per_cu); per_cu = 1; }
        (void)hipGetLastError();
        grid = cus * per_cu;
    }
    if (grid < 0) return;
    hipMemsetAsync((char*)d_ws + WS_CTL, 0, CTL_BYTES, stream);
    Args a{};
    a.x = (const float*)d_in[0]; a.ng = (const float*)d_in[1]; a.w_in = (const float*)d_in[2]; a.qg = (const float*)d_in[3]; a.kg = (const float*)d_in[4];
    a.fb = (const float*)d_in[5]; a.w_out = (const float*)d_in[6]; a.out = (float*)d_out; a.ws = (unsigned char*)d_ws;
    for (int j = 0; j < 32; ++j) a.inv_freq[j] = (float)(1.0 / pow(10000.0, (double)j / 32.0));
    void* args[] = {&a};
    hipError_t e = hipLaunchCooperativeKernel((const void*)mega_fwd, dim3(grid), dim3(512), args, LDS_BYTES, stream);
    if (e != hipSuccess) fprintf(stderr, "kernel_launch: cooperative launch failed: %s (grid %d)\n", hipGetErrorString(e), grid);
}
```

```cpp
#include <hip/hip_runtime.h>
#include <hip/hip_cooperative_groups.h>
#include <cstdio>
#include <cstdint>
#include <cmath>
namespace cg = cooperative_groups;
namespace pg8 {
#define PG8_LAS __attribute__((address_space(3)))
typedef unsigned short bf16_t;
typedef short bf16x8 __attribute__((ext_vector_type(8)));
typedef float f32x4 __attribute__((ext_vector_type(4)));
typedef unsigned u32x4 __attribute__((ext_vector_type(4)));
constexpr int BM = 256, BK = 64, HALF = 128, HTB = HALF * BK * 2  , STAGE_BYTES = 8 * HTB, NXCD = 8, WGM = 8;

__host__ __device__ __forceinline__ int lds_byte(int r, int c) { const int st = (r >> 4) * 2 + (c >> 5), rr = r & 15, cc = c & 31, ob = rr * 64 + cc * 2; return st * 1024 + (ob ^ (((ob >> 9) & 1) << 5)); }
__host__ __device__ __forceinline__ void stage_rc(int b, int& R, int& C) { const int st = b / 1024, sb = b % 1024, swz = sb ^ (((sb >> 9) & 1) << 5); R = (st >> 1) * 16 + swz / 64; C = (st & 1) * 32 + (swz % 64) / 2; }
__host__ __device__ __forceinline__ int perm32(int rho) { const int n = rho >> 4, i = rho & 15; return 8 * (i >> 2) + 4 * n + (i & 3); }

struct Unit { int pm, pn; };
struct Gemm { const bf16_t* A; const bf16_t* Bt; int M, N, K; };

struct StaticOrder {
    int nM, nN, nwg, G, c;
    __host__ __device__ void init(int M, int N, int G_, int c_) { nM = M / BM; nN = N / BM; nwg = nM * nN; G = G_; c = c_; }
    __host__ __device__ bool next(int i, Unit& u) const {
        const long L = (long)i * G + c; if (L >= nwg) return false;
        int wgid = (int)L; { const int q = nwg / NXCD, r = nwg % NXCD, xcd = wgid % NXCD, off = wgid / NXCD; wgid = (xcd < r ? xcd * (q + 1) : r * (q + 1) + (xcd - r) * q) + off; }
        const int nig = WGM * nN, gid = wgid / nig, fm = gid * WGM, gsz = (nM - fm) < WGM ? (nM - fm) : WGM;
        u.pm = fm + ((wgid % nig) % gsz); u.pn = (wgid % nig) / gsz; return true;
    }
    __device__ __forceinline__ void a_ready(const Unit&) const {}
    __device__ __forceinline__ void done(const Unit&) const {}
};

__device__ __forceinline__ unsigned cvt_pk_bf16(float lo, float hi) { unsigned r; asm volatile("v_cvt_pk_bf16_f32 %0, %1, %2" : "=v"(r) : "v"(lo), "v"(hi)); return r; }
typedef float f32x2 __attribute__((ext_vector_type(2)));
template <class Epi, class Sched, bool ALIGN_EPI = false, bool SP2 = false>
__device__ __forceinline__ void gemm_phase(PG8_LAS unsigned char* lds, const Gemm g, const Sched& S, const Epi& E) {
    int tid_ = threadIdx.x; asm volatile("" : "+v"(tid_));
    const int tid = tid_, wid = __builtin_amdgcn_readfirstlane(tid >> 6), lane = tid & 63, wr = wid >> 2, wc = wid & 3, fr = lane & 15, fq = lane >> 4;
    const int K = g.K, nt = K / BK;
    unsigned voffA[2], voffB[2];
#pragma unroll
    for (int i = 0; i < 2; ++i) { int R, C; stage_rc(tid * 16 + i * 8192, R, C); const int Rb = Epi::PERM ? ((R & ~31) + perm32(R & 31)) : R;
        voffA[i] = (unsigned)(R * K + C) * 2u; voffB[i] = (unsigned)(Rb * K + C) * 2u; }
    const size_t kstep = (size_t)(BK * 2);
    const size_t hstep = (size_t)HALF * K * 2;
    const size_t tstep = 2 * hstep;
    const unsigned ldsw = (unsigned)wid * 1024u;
    const int aoff = lds_byte(wr * 64 + fr, fq * 8), boff = lds_byte(wc * 32 + fr, fq * 8);
#define PG8_SA(b, h) (((b) * 2 + (h)) * HTB)
#define PG8_SB(b, h) ((4 + (b) * 2 + (h)) * HTB)
#define PG8_STAGE(bufoff, gbase, voff) do { _Pragma("unroll") for (int _i = 0; _i < 2; ++_i) \
        __builtin_amdgcn_global_load_lds((const unsigned*)((const char*)(gbase) + (voff)[_i]), (PG8_LAS unsigned*)(lds + (bufoff) + ldsw + _i * 8192), 16, 0, 0); } while (0)
#define PG8_LDA(dst, b, h) do { _Pragma("unroll") for (int m = 0; m < 4; ++m) _Pragma("unroll") for (int k = 0; k < 2; ++k) dst[m][k] = *(const PG8_LAS bf16x8*)(lds + PG8_SA(b, h) + aoff + m * 2048 + k * 1024); } while (0)
#define PG8_LDB(dst, b, h) do { _Pragma("unroll") for (int n = 0; n < 2; ++n) _Pragma("unroll") for (int k = 0; k < 2; ++k) dst[n][k] = *(const PG8_LAS bf16x8*)(lds + PG8_SB(b, h) + boff + n * 2048 + k * 1024); } while (0)
#define PG8_MMA(ai, bj, At, Bt) do { __builtin_amdgcn_s_setprio(1); _Pragma("unroll") for (int m = 0; m < 4; ++m) _Pragma("unroll") for (int n = 0; n < 2; ++n) _Pragma("unroll") for (int k = 0; k < 2; ++k) \
        acc[ai][bj][m][n] = __builtin_amdgcn_mfma_f32_16x16x32_bf16(Bt[n][k], At[m][k], acc[ai][bj][m][n], 0, 0, 0); __builtin_amdgcn_s_setprio(0); } while (0)
#define PG8_WAIT_V(n) asm volatile("s_waitcnt vmcnt(" #n ")" ::: "memory")
#define PG8_WAIT_L(n) asm volatile("s_waitcnt lgkmcnt(" #n ")" ::: "memory")
#define PG8_BAR __builtin_amdgcn_s_barrier()
#define PG8_SCHED __builtin_amdgcn_sched_barrier(0)
    Unit cur, nxt; int ui = 0;
    if (!S.next(0, cur)) return;
    f32x4 acc[2][2][4][2];
#pragma unroll
    for (int a = 0; a < 2; ++a)
#pragma unroll
        for (int b = 0; b < 2; ++b)
#pragma unroll
            for (int m = 0; m < 4; ++m)
#pragma unroll
                for (int n = 0; n < 2; ++n) acc[a][b][m][n] = (f32x4){0.f, 0.f, 0.f, 0.f};
    bf16x8 At[4][2], B0[2][2], B1[2][2];
    const char* cA = (const char*)g.A + (size_t)cur.pm * tstep; const char* cB = (const char*)g.Bt + (size_t)cur.pn * tstep;
    S.a_ready(cur);
    if constexpr (SP2) {
        PG8_STAGE(PG8_SB(0, 0), cB, voffB); PG8_STAGE(PG8_SB(0, 1), cB + hstep, voffB); PG8_STAGE(PG8_SA(0, 0), cA, voffA); PG8_STAGE(PG8_SA(0, 1), cA + hstep, voffA);
        if (wr == 1) PG8_BAR;
        PG8_WAIT_V(2); PG8_BAR;
        PG8_STAGE(PG8_SB(1, 0), cB + kstep, voffB); PG8_STAGE(PG8_SA(1, 0), cA + kstep, voffA); PG8_STAGE(PG8_SB(1, 1), cB + hstep + kstep, voffB);
        PG8_WAIT_V(6); PG8_BAR;
    } else {
        PG8_STAGE(PG8_SB(0, 0), cB, voffB); PG8_STAGE(PG8_SA(0, 0), cA, voffA); PG8_STAGE(PG8_SB(0, 1), cB + hstep, voffB); PG8_STAGE(PG8_SA(0, 1), cA + hstep, voffA);
        if (wr == 1) PG8_BAR;
        PG8_WAIT_V(4); PG8_BAR;
        PG8_STAGE(PG8_SB(1, 0), cB + kstep, voffB); PG8_STAGE(PG8_SA(1, 0), cA + kstep, voffA); PG8_STAGE(PG8_SB(1, 1), cB + hstep + kstep, voffB);
        PG8_WAIT_V(6); PG8_BAR;
    }
    for (;;) {
        const bool has_next = S.next(ui + 1, nxt);
        const char* nA = has_next ? (const char*)g.A + (size_t)nxt.pm * tstep : cA; const char* nB = has_next ? (const char*)g.Bt + (size_t)nxt.pn * tstep : cB;
        for (int t = 0; t < nt; t += 2) {
            const bool last = (t == nt - 2);
            const char* a1 = cA + (size_t)(t + 1) * kstep;
            const char* a2 = last ? nA : cA + (size_t)(t + 2) * kstep; const char* b2 = last ? nB : cB + (size_t)(t + 2) * kstep;
            const char* a3 = a2 + kstep; const char* b3 = b2 + kstep;
            if (last && has_next) S.a_ready(nxt);
            if constexpr (SP2) {
            PG8_LDB(B0, 0, 0); PG8_LDB(B1, 0, 1); PG8_SCHED; PG8_LDA(At, 0, 0); PG8_STAGE(PG8_SA(1, 1), a1 + hstep, voffA);
            PG8_WAIT_V(8); PG8_WAIT_L(0); PG8_BAR; PG8_MMA(0, 0, At, B0); PG8_MMA(0, 1, At, B1); PG8_BAR; PG8_SCHED;
            PG8_LDA(At, 0, 1); PG8_STAGE(PG8_SB(0, 0), b2, voffB); PG8_STAGE(PG8_SB(0, 1), b2 + hstep, voffB); PG8_STAGE(PG8_SA(0, 0), a2, voffA);
            PG8_WAIT_V(8); PG8_WAIT_L(0); PG8_BAR; PG8_MMA(1, 0, At, B0); PG8_MMA(1, 1, At, B1); PG8_BAR; PG8_SCHED;
            PG8_LDB(B0, 1, 0); PG8_LDB(B1, 1, 1); PG8_SCHED; PG8_LDA(At, 1, 0); PG8_STAGE(PG8_SA(0, 1), a2 + hstep, voffA);
            PG8_WAIT_V(8); PG8_WAIT_L(0); PG8_BAR; PG8_MMA(0, 0, At, B0); PG8_MMA(0, 1, At, B1); PG8_BAR; PG8_SCHED;
            PG8_LDA(At, 1, 1); PG8_STAGE(PG8_SB(1, 0), b3, voffB); PG8_STAGE(PG8_SB(1, 1), b3 + hstep, voffB); PG8_STAGE(PG8_SA(1, 0), a3, voffA);
            PG8_WAIT_V(8); PG8_WAIT_L(0); PG8_BAR; PG8_MMA(1, 0, At, B0); PG8_MMA(1, 1, At, B1); PG8_BAR; PG8_SCHED;
            } else {
            PG8_LDB(B0, 0, 0); PG8_SCHED; PG8_LDA(At, 0, 0); PG8_STAGE(PG8_SA(1, 1), a1 + hstep, voffA);
            PG8_WAIT_L(8); PG8_BAR; PG8_WAIT_L(0); PG8_MMA(0, 0, At, B0); PG8_BAR; PG8_SCHED;
            PG8_LDB(B1, 0, 1); PG8_STAGE(PG8_SB(0, 0), b2, voffB);
            PG8_BAR; PG8_WAIT_L(0); PG8_MMA(0, 1, At, B1); PG8_BAR;
            PG8_LDA(At, 0, 1); PG8_STAGE(PG8_SA(0, 0), a2, voffA);
            PG8_BAR; PG8_WAIT_L(0); PG8_MMA(1, 0, At, B0); PG8_BAR; PG8_SCHED;
            PG8_STAGE(PG8_SB(0, 1), b2 + hstep, voffB);
            PG8_WAIT_V(6); PG8_BAR; PG8_MMA(1, 1, At, B1); PG8_BAR;
            PG8_LDB(B0, 1, 0); PG8_SCHED; PG8_LDA(At, 1, 0); PG8_STAGE(PG8_SA(0, 1), a2 + hstep, voffA);
            PG8_WAIT_L(8); PG8_BAR; PG8_WAIT_L(0); PG8_MMA(0, 0, At, B0); PG8_BAR; PG8_SCHED;
            PG8_LDB(B1, 1, 1); PG8_STAGE(PG8_SB(1, 0), b3, voffB);
            PG8_BAR; PG8_WAIT_L(0); PG8_MMA(0, 1, At, B1); PG8_BAR;
            PG8_LDA(At, 1, 1); PG8_STAGE(PG8_SA(1, 0), a3, voffA);
            PG8_BAR; PG8_WAIT_L(0); PG8_MMA(1, 0, At, B0); PG8_BAR; PG8_SCHED;
            PG8_STAGE(PG8_SB(1, 1), b3 + hstep, voffB);
            PG8_WAIT_V(6); PG8_BAR; PG8_MMA(1, 1, At, B1); PG8_BAR;
            }
        }
        if constexpr (ALIGN_EPI) { if (wr == 0) PG8_BAR; }
        if constexpr (!Epi::AFTER_DRAIN) { E(acc, cur, wr, wc, fr, fq); S.done(cur); }
        if (!has_next) break;
#pragma unroll
        for (int a = 0; a < 2; ++a)
#pragma unroll
            for (int b = 0; b < 2; ++b)
#pragma unroll
                for (int m = 0; m < 4; ++m)
#pragma unroll
                    for (int n = 0; n < 2; ++n) acc[a][b][m][n] = (f32x4){0.f, 0.f, 0.f, 0.f};
        cur = nxt; cA = nA; cB = nB; ++ui;
        if constexpr (ALIGN_EPI) { if (wr == 1) PG8_BAR; }
    }
    PG8_WAIT_V(0);
    if constexpr (!ALIGN_EPI) { if (wr == 0) PG8_BAR; }
    PG8_BAR;
    if constexpr (Epi::AFTER_DRAIN) { E.fused(acc, cur, wr, wc, fr, fq, lds, wid, lane); S.done(cur); }
#undef PG8_SA
#undef PG8_SB
#undef PG8_STAGE
#undef PG8_LDA
#undef PG8_LDB
#undef PG8_MMA
#undef PG8_WAIT_V
#undef PG8_WAIT_L
#undef PG8_BAR
#undef PG8_SCHED
}
}

#define DI __device__ __forceinline__
#define LAS __attribute__((address_space(3)))
typedef unsigned short bf16_t;
typedef short bf16x8 __attribute__((ext_vector_type(8)));
typedef short s16x4 __attribute__((ext_vector_type(4)));
typedef float f32x4 __attribute__((ext_vector_type(4)));
typedef float f32x8 __attribute__((ext_vector_type(8)));
typedef float f32x16 __attribute__((ext_vector_type(16)));
typedef unsigned u32x4 __attribute__((ext_vector_type(4)));
typedef unsigned u32x2 __attribute__((ext_vector_type(2)));
typedef __bf16 bf8v __attribute__((ext_vector_type(8)));
typedef __bf16 bf4v __attribute__((ext_vector_type(4)));

constexpr int NB = 2, S = 8192, DM = 2048, MT = NB * S, NL = 4, HD = 64, NCOL = 8200, NPROJ = 8192;
constexpr float LOG2E = 1.4426950408889634f, LN2 = 0.6931471805599453f;
constexpr size_t MiB = 1u << 20;
constexpr size_t WS_CTL = 0, CTL_BYTES = 65536;
constexpr size_t WS_WIN = 1 * MiB;
constexpr size_t WS_WOUT = 129 * MiB;
constexpr size_t WS_XB = 161 * MiB;
constexpr size_t WS_Q = 225 * MiB;
constexpr size_t WS_K = 289 * MiB;
constexpr size_t WS_VT = 353 * MiB;
constexpr size_t WS_VTX = 417 * MiB;
constexpr size_t WS_G = 449 * MiB;
constexpr size_t WS_Y = 513 * MiB;
constexpr size_t WS_LOGF = 577 * MiB;
constexpr size_t WS_F = WS_LOGF + 512 * 1024;
constexpr size_t WS_KMP = 578 * MiB;
constexpr size_t WS_COS = 579 * MiB, WS_SIN = 580 * MiB;
constexpr size_t WS_WF = 581 * MiB;
constexpr size_t WS_END = 582 * MiB;
constexpr int LDS_BYTES = 147456;

struct Args { const float *x, *ng, *w_in, *qg, *kg, *fb, *w_out; float* out; unsigned char* ws; float inv_freq[32]; };

DI unsigned f2bf(float f) { unsigned u = __builtin_bit_cast(unsigned, f); return (u + 0x7fffu + ((u >> 16) & 1u)) >> 16; }
DI unsigned pk2(float lo, float hi) { return f2bf(lo) | (f2bf(hi) << 16); }
DI float bf2f(unsigned short b) { return __builtin_bit_cast(float, (unsigned)b << 16); }
DI bf16x8 pack8(f32x8 v) { bf8v b = __builtin_convertvector(v, bf8v); return __builtin_bit_cast(bf16x8, b); }
DI s16x4 pack4(f32x4 v) { bf4v b = __builtin_convertvector(v, bf4v); return __builtin_bit_cast(s16x4, b); }
template <int O> DI int shxi(int v) {
    if constexpr (O < 32) return __builtin_amdgcn_ds_swizzle(v, 0x1f | (O << 10));
    else { const auto r = __builtin_amdgcn_permlane32_swap((unsigned)v, (unsigned)v, false, false); return (int)((threadIdx.x & 32u) ? r[0] : r[1]); }
}
template <int O> DI float shx(float v) { return __builtin_bit_cast(float, shxi<O>(__builtin_bit_cast(int, v))); }
DI float wave_sum(float v) { v += shx<1>(v); v += shx<2>(v); v += shx<4>(v); v += shx<8>(v); v += shx<16>(v); v += shx<32>(v); return v; }
DI float wave_max(float v) { v = fmaxf(v, shx<1>(v)); v = fmaxf(v, shx<2>(v)); v = fmaxf(v, shx<4>(v)); v = fmaxf(v, shx<8>(v)); v = fmaxf(v, shx<16>(v)); v = fmaxf(v, shx<32>(v)); return v; }
DI f32x16 mfma32(bf16x8 a, bf16x8 b, f32x16 c) { return __builtin_amdgcn_mfma_f32_32x32x16_bf16(a, b, c, 0, 0, 0); }
DI float ex2(float x) { return __builtin_amdgcn_exp2f(x); }
DI float lg2(float x) { return __builtin_amdgcn_logf(x); }

struct EpiIn {
    static constexpr bool PERM = true, AFTER_DRAIN = false;
    bf16_t *Q, *K, *VT, *VTX, *G; float* KMP; const float *qg, *kg, *cosT, *sinT;
    __device__ __forceinline__ void operator()(const pg8::f32x4 (&acc)[2][2][4][2], const pg8::Unit& u, int wr, int wc, int fr, int fq) const {
        const int ms = (u.pn & 7) >> 1, mixer = ((ms & 1) << 1) | (ms >> 1);
        const int sec = u.pn >> 3, head = 4 * (u.pn & 1) + wc;
        const int b = u.pm >> 5, blk = u.pm & 31, sbase = blk * 256 + wr * 64 + fr, bh = b * 8 + head;
        if (sec <= 1) {
            const bool norm = mixer != 1, rope = (mixer == 0 || mixer == 2), km = (sec == 1 && mixer == 2);
            const float* gp = (sec == 0 ? qg : kg) + (mixer == 0 ? 0 : (mixer == 2 ? 1 : 2)) * 64;
            f32x4 gn[2][2], ks[2][2];
#pragma unroll
            for (int bj = 0; bj < 2; ++bj)
#pragma unroll
                for (int n = 0; n < 2; ++n) { gn[bj][n] = norm ? *(const f32x4*)(gp + 32 * bj + 8 * fq + 4 * n) : (f32x4){1.f, 1.f, 1.f, 1.f}; ks[bj][n] = (f32x4){0.f, 0.f, 0.f, 0.f}; }
            bf16_t* dst = (sec == 0 ? Q : K) + (size_t)(mixer * 16 + bh) * S * 64;
            const float osc = sec == 0 ? (mixer == 1 ? 0.125f : 0.125f * LOG2E) : 1.0f;
#pragma unroll
            for (int ai = 0; ai < 2; ++ai)
#pragma unroll
                for (int m = 0; m < 4; ++m) {
                    const int s = sbase + 128 * ai + 16 * m;
                    f32x4 v[2][2];
#pragma unroll
                    for (int bj = 0; bj < 2; ++bj)
#pragma unroll
                        for (int n = 0; n < 2; ++n) v[bj][n] = acc[ai][bj][m][n];
                    if (norm) {
                        float ss = 0.f;
#pragma unroll
                        for (int bj = 0; bj < 2; ++bj)
#pragma unroll
                            for (int n = 0; n < 2; ++n) { const f32x4 t = v[bj][n]; ss += (t[0] * t[0] + t[1] * t[1]) + (t[2] * t[2] + t[3] * t[3]); }
                        ss += shx<16>(ss); ss += shx<32>(ss);
                        const float rr = rsqrtf(ss * (1.0f / 64.0f) + 1e-6f);
#pragma unroll
                        for (int bj = 0; bj < 2; ++bj)
#pragma unroll
                            for (int n = 0; n < 2; ++n) v[bj][n] = v[bj][n] * rr * gn[bj][n];
                    }
                    if (rope) {
#pragma unroll
                        for (int n = 0; n < 2; ++n) {
                            const f32x4 c4 = *(const f32x4*)(cosT + (size_t)s * 32 + 8 * fq + 4 * n), s4 = *(const f32x4*)(sinT + (size_t)s * 32 + 8 * fq + 4 * n);
                            const f32x4 t1 = v[0][n], t2 = v[1][n];
                            v[0][n] = t1 * c4 - t2 * s4; v[1][n] = t2 * c4 + t1 * s4;
                        }
                    }
                    if (km) {
#pragma unroll
                        for (int bj = 0; bj < 2; ++bj)
#pragma unroll
                            for (int n = 0; n < 2; ++n) ks[bj][n] += v[bj][n];
                    }
#pragma unroll
                    for (int bj = 0; bj < 2; ++bj) {
                        const f32x4 a0 = v[bj][0] * osc, a1 = v[bj][1] * osc;
                        const bf16x8 w = pack8((f32x8){a0[0], a0[1], a0[2], a0[3], a1[0], a1[1], a1[2], a1[3]});
                        *(bf16x8*)(dst + (size_t)s * 64 + 32 * bj + 8 * fq) = w;
                    }
                }
            if (km) {
#pragma unroll
                for (int bj = 0; bj < 2; ++bj)
#pragma unroll
                    for (int n = 0; n < 2; ++n) {
                        f32x4 t = ks[bj][n];
#pragma unroll
                        for (int e = 0; e < 4; ++e) { float x = t[e]; x += shx<1>(x); x += shx<2>(x); x += shx<4>(x); x += shx<8>(x); t[e] = x; }
                        if (fr == 0) *(f32x4*)(KMP + ((size_t)(bh * 32 + blk) * 2 + wr) * 64 + 32 * bj + 8 * fq + 4 * n) = t;
                    }
            }
        } else if (sec == 2) {
            bf16_t* vt = VT + (size_t)(mixer * 16 + bh) * 64 * S;
            bf16_t* vx0 = VTX + (size_t)bh * 64 * S;
            bf16_t* vx1 = VTX + (size_t)(16 + bh) * 64 * S;
#pragma unroll
            for (int ai = 0; ai < 2; ++ai)
#pragma unroll
                for (int m = 0; m < 4; ++m) {
                    const int s = sbase + 128 * ai + 16 * m;
                    const int s4 = (s & 3) * (S / 4) + (s >> 2), s16 = (s & 15) * (S / 16) + (s >> 4);
#pragma unroll
                    for (int bj = 0; bj < 2; ++bj)
#pragma unroll
                        for (int n = 0; n < 2; ++n)
#pragma unroll
                            for (int e = 0; e < 4; ++e) {
                                const int d = 32 * bj + 8 * fq + 4 * n + e;
                                const bf16_t w = (bf16_t)f2bf(acc[ai][bj][m][n][e]);
                                vt[(size_t)d * S + s] = w;
                            }
                }
            if (mixer == 0) {
#pragma unroll
                for (int ai = 0; ai < 2; ++ai) {
                    const int s0 = sbase + 128 * ai, s16 = (s0 & 15) * (S / 16) + (s0 >> 4);
                    const int s4p = (fr & 3) * (S / 4) + ((s0 - fr) >> 2) + 4 * (fr >> 2);
#pragma unroll
                    for (int bj = 0; bj < 2; ++bj)
#pragma unroll
                        for (int n = 0; n < 2; ++n)
#pragma unroll
                            for (int e = 0; e < 4; ++e) {
                                const int d = 32 * bj + 8 * fq + 4 * n + e;
                                const f32x4 t = {acc[ai][bj][0][n][e], acc[ai][bj][1][n][e], acc[ai][bj][2][n][e], acc[ai][bj][3][n][e]};
                                const s16x4 w4 = pack4(t);
                                *(s16x4*)(vx1 + (size_t)d * S + s16) = w4;
                                *(s16x4*)(vx0 + (size_t)d * S + s4p) = w4;
                            }
                }
            }
        } else {
            const int col = 512 * mixer + 256 * (u.pn & 1) + 64 * wc + 8 * fq;
#pragma unroll
            for (int ai = 0; ai < 2; ++ai)
#pragma unroll
                for (int m = 0; m < 4; ++m) {
                    const size_t row = (size_t)u.pm * 256 + 128 * ai + 64 * wr + 16 * m + fr;
#pragma unroll
                    for (int bj = 0; bj < 2; ++bj) {
                        f32x8 t;
#pragma unroll
                        for (int n = 0; n < 2; ++n)
#pragma unroll
                            for (int e = 0; e < 4; ++e) { const float z = acc[ai][bj][m][n][e]; t[4 * n + e] = z / (1.0f + __expf(-z)); }
                        *(bf16x8*)(G + row * DM + col + 32 * bj) = pack8(t);
                    }
                }
        }
    }
};
struct EpiOut {
    static constexpr bool PERM = false, AFTER_DRAIN = false;
    const float* src; float* out;
    __device__ __forceinline__ void operator()(const pg8::f32x4 (&acc)[2][2][4][2], const pg8::Unit& u, int wr, int wc, int fr, int fq) const {
#pragma unroll
        for (int ai = 0; ai < 2; ++ai)
#pragma unroll
            for (int m = 0; m < 4; ++m) {
                const size_t row = (size_t)u.pm * 256 + 128 * ai + 64 * wr + 16 * m + fr;
#pragma unroll
                for (int bj = 0; bj < 2; ++bj)
#pragma unroll
                    for (int n = 0; n < 2; ++n) {
                        const size_t off = row * DM + u.pn * 256 + 128 * bj + 32 * wc + 16 * n + 4 * fq;
                        const f32x4 r = *(const f32x4*)(src + off);
                        *(f32x4*)(out + off) = r + acc[ai][bj][m][n];
                    }
                asm volatile("" ::: "memory");
            }
    }
};

DI void transpose_item(const float* W, int ldw, const float* gain, bf16_t* WT, int K, int k0, int n0, int nd, LAS float* scr, int lane) {
    f32x4 tw[8]; float gg[8];
#pragma unroll
    for (int i = 0; i < 8; ++i) { const int kk = 8 * i + (lane >> 3); tw[i] = *(const f32x4*)(W + (size_t)(k0 + kk) * ldw + n0 + 4 * (lane & 7)); gg[i] = gain ? gain[k0 + kk] : 1.0f; }
#pragma unroll
    for (int i = 0; i < 8; ++i) { const int kk = 8 * i + (lane >> 3); LAS float* d = scr + kk * 33 + 4 * (lane & 7);
        d[0] = tw[i][0] * gg[i]; d[1] = tw[i][1] * gg[i]; d[2] = tw[i][2] * gg[i]; d[3] = tw[i][3] * gg[i]; }
    asm volatile("s_waitcnt lgkmcnt(0)" ::: "memory");
    const int c = lane & 7;
#pragma unroll
    for (int j = 0; j < 4; ++j) { const int n = (lane >> 3) + 8 * j; const LAS float* s = scr + (8 * c) * 33 + n;
        u32x4 o; o.x = pk2(s[0 * 33], s[1 * 33]); o.y = pk2(s[2 * 33], s[3 * 33]); o.z = pk2(s[4 * 33], s[5 * 33]); o.w = pk2(s[6 * 33], s[7 * 33]);
        *(u32x4*)(WT + (size_t)(nd + n) * K + k0 + 8 * c) = o; }
    asm volatile("s_waitcnt lgkmcnt(0)" ::: "memory");
}

DI void norm_row(const float* xrow, const LAS f32x4* wfl, const float* fbias, bf16_t* orow, float* logf_b  , int s, int lane) {
    asm volatile("" ::: "memory");
    f32x4 v[8]; float ss = 0.f; float fl[8];
#pragma unroll
    for (int h = 0; h < 8; ++h) fl[h] = 0.f;
#pragma unroll
    for (int j = 0; j < 8; ++j) { v[j] = ((const f32x4*)xrow)[lane + 64 * j]; ss += (v[j][0] * v[j][0] + v[j][1] * v[j][1]) + (v[j][2] * v[j][2] + v[j][3] * v[j][3]); }
#pragma unroll
    for (int j = 0; j < 8; ++j) {
#pragma unroll
        for (int e = 0; e < 4; ++e) {
            const float xg = v[j][e];
            const f32x4 w0 = wfl[((j * 4 + e) * 2 + 0) * 64 + lane], w1 = wfl[((j * 4 + e) * 2 + 1) * 64 + lane];
            fl[0] += xg * w0[0]; fl[1] += xg * w0[1]; fl[2] += xg * w0[2]; fl[3] += xg * w0[3];
            fl[4] += xg * w1[0]; fl[5] += xg * w1[1]; fl[6] += xg * w1[2]; fl[7] += xg * w1[3];
        }
    }
    ss = wave_sum(ss);
#pragma unroll
    for (int h = 0; h < 8; ++h) fl[h] = wave_sum(fl[h]);
    const float rstd = rsqrtf(ss * (1.0f / DM) + 1e-6f);
    unsigned long long* o8 = (unsigned long long*)orow + lane;
#pragma unroll
    for (int j = 0; j < 8; ++j) o8[64 * j] = (unsigned long long)pk2(v[j][0] * rstd, v[j][1] * rstd) | ((unsigned long long)pk2(v[j][2] * rstd, v[j][3] * rstd) << 32);
    float mine = fl[0];
#pragma unroll
    for (int h = 1; h < 8; ++h) mine = (lane == h) ? fl[h] : mine;
    if (lane < 8) {
        const float z = mine * rstd + fbias[lane];
        const float lf = fminf(z, 0.f) - log1pf(expf(-fabsf(z)));
        logf_b[(size_t)lane * S + s] = lf;
    }
}

DI int crow(int i, int h) { return (i & 3) + 8 * (i >> 2) + 4 * h; }
DI int kperm(int r) { return (r & ~12) | ((r & 4) << 1) | ((r & 8) >> 1); }
DI int kidx(int i, int h) { return 16 * (i >> 3) + 8 * h + (i & 7); }
DI int uperm(int x, bool on) { return on ? ((x & ~15) | ((x & 3) << 2) | ((x >> 2) & 3)) : x; }
DI void load_q(bf16x8 (&qf)[4], const bf16_t* qrow) {
#pragma unroll
    for (int sp = 0; sp < 4; ++sp) qf[sp] = *(const bf16x8*)(qrow + 16 * sp);
}
DI void load_v(bf16x8 (&vf)[2][2], const bf16_t* vb  ) {
#pragma unroll
    for (int dd = 0; dd < 2; ++dd)
#pragma unroll
        for (int s = 0; s < 2; ++s) vf[dd][s] = *(const bf16x8*)(vb + (size_t)dd * 32 * S + 16 * s);
}
DI f32x16 qk_tile(const bf16x8 (&kf)[4], const bf16x8 (&qf)[4]) {
    f32x16 x;
#pragma unroll
    for (int i = 0; i < 16; ++i) x[i] = 0.f;
#pragma unroll
    for (int sp = 0; sp < 4; ++sp) x = mfma32(kf[sp], qf[sp], x);
    return x;
}
DI void pv_tile(f32x16& o0, f32x16& o1, const bf16x8 (&vf)[2][2], const float (&p)[16]) {
    const bf16x8 p0 = pack8((f32x8){p[0], p[1], p[2], p[3], p[4], p[5], p[6], p[7]});
    const bf16x8 p1 = pack8((f32x8){p[8], p[9], p[10], p[11], p[12], p[13], p[14], p[15]});
    o0 = mfma32(vf[0][0], p0, o0); o0 = mfma32(vf[0][1], p1, o0);
    o1 = mfma32(vf[1][0], p0, o1); o1 = mfma32(vf[1][1], p1, o1);
}
DI void store_y(const f32x16& o0, const f32x16& o1, float inv, const bf16_t* G, bf16_t* Y, size_t row, int col0, int h) {
#pragma unroll
    for (int dd = 0; dd < 2; ++dd)
#pragma unroll
        for (int g = 0; g < 4; ++g) {
            const size_t off = row * DM + col0 + 32 * dd + 8 * g + 4 * h;
            const s16x4 gt = *(const s16x4*)(G + off);
            f32x4 t;
#pragma unroll
            for (int e = 0; e < 4; ++e) t[e] = (dd == 0 ? o0[4 * g + e] : o1[4 * g + e]) * inv * bf2f((unsigned short)gt[e]);
            *(s16x4*)(Y + off) = pack4(t);
        }
}

template <int MODE>
DI void attn_item(const bf16_t* Qm, const bf16_t* Km, const bf16_t* Vtm, const float* Fb, const float* KMPb, const bf16_t* G, bf16_t* Y, int bh, int qt, int mixer, float Mb, int lane) {
    asm volatile("" : "+v"(lane));
    const int r = lane & 31, h = lane >> 5;
    const int q0 = qt * 32, t = q0 + r;
    bf16x8 qf[4];
    load_q(qf, Qm + ((size_t)bh * S + t) * 64 + 8 * h);
    const bf16_t* kb = Km + ((size_t)bh * S + kperm(r)) * 64 + 8 * h;
    const bf16_t* vb = Vtm + ((size_t)bh * 64 + r) * S + 8 * h;
    const int qblk = qt >> 3;
    unsigned sel = 0u, vis = 0xffffffffu;
    float ft = 0.f, Ft0 = 0.f;
    if (MODE == 3) { ft = Fb[t]; Ft0 = Fb[q0]; }
    if (MODE == 2) {
        if (qblk > 0) {
            f32x16 gx;
#pragma unroll
            for (int i = 0; i < 16; ++i) gx[i] = 0.f;
#pragma unroll
            for (int sp = 0; sp < 4; ++sp) {
                const float* kp = KMPb + (size_t)(r * 2) * 64 + 16 * sp + 8 * h;
                const f32x4 a0 = *(const f32x4*)kp, a1 = *(const f32x4*)(kp + 4), b0 = *(const f32x4*)(kp + 64), b1 = *(const f32x4*)(kp + 68);
                f32x8 km, hi_f;
#pragma unroll
                for (int e = 0; e < 4; ++e) { km[e] = (a0[e] + b0[e]) * (1.0f / 256.0f); km[4 + e] = (a1[e] + b1[e]) * (1.0f / 256.0f); }
                const bf16x8 hi = pack8(km);
#pragma unroll
                for (int e = 0; e < 8; ++e) hi_f[e] = km[e] - bf2f((unsigned short)hi[e]);
                const bf16x8 lo = pack8(hi_f);
                gx = mfma32(hi, qf[sp], gx); gx = mfma32(lo, qf[sp], gx);
            }
            const float NEGI = -__builtin_inff();
#pragma unroll
            for (int i = 0; i < 16; ++i) if (crow(i, h) >= qblk) gx[i] = NEGI;
#pragma unroll
            for (int it = 0; it < 3; ++it) {
                float bv = NEGI; int bn = 64;
#pragma unroll
                for (int i = 0; i < 16; ++i) if (gx[i] > bv) { bv = gx[i]; bn = crow(i, h); }
                const float pv = shx<32>(bv); const int pn = shxi<32>(bn);
                if (pv > bv || (pv == bv && pn < bn)) { bv = pv; bn = pn; }
                if (bv > NEGI) sel |= 1u << bn;
#pragma unroll
                for (int i = 0; i < 16; ++i) if (crow(i, h) == bn) gx[i] = NEGI;
            }
        }
        vis = sel;
        vis |= (unsigned)shxi<1>((int)vis); vis |= (unsigned)shxi<2>((int)vis); vis |= (unsigned)shxi<4>((int)vis); vis |= (unsigned)shxi<8>((int)vis); vis |= (unsigned)shxi<16>((int)vis); vis |= (unsigned)shxi<32>((int)vis);
        vis |= 1u << qblk;
    }
    f32x16 o0, o1;
#pragma unroll
    for (int i = 0; i < 16; ++i) { o0[i] = 0.f; o1[i] = 0.f; }
    float l = 0.f, R = 0.f;
    const float mb2 = -Mb * LOG2E;

    int tau = qt;
    bf16x8 kfA[4], vfA[2][2]; f32x4 fsA[4];
    load_q(kfA, kb + (size_t)tau * 32 * 64);
    load_v(vfA, vb + tau * 32);
    if (MODE == 3) {
#pragma unroll
        for (int g = 0; g < 4; ++g) fsA[g] = *(const f32x4*)(Fb + tau * 32 + 16 * (g >> 1) + 8 * h + 4 * (g & 1));
    }
    while (tau >= 0) {
        int nxt = tau - 1;
        if (MODE == 2) { while (nxt >= 0 && !((vis >> (nxt >> 3)) & 1u)) nxt = (nxt >> 3) * 8 - 1; }
        if (MODE == 3) { if (nxt >= 0) { const float fk = Fb[nxt * 32 + 31]; if ((Ft0 - fk) + 2.0f * Mb < -104.0f) nxt = -1; } }
        nxt = __builtin_amdgcn_readfirstlane(nxt);
        bf16x8 kfB[4], vfB[2][2]; f32x4 fsB[4];
#pragma unroll
        for (int sp = 0; sp < 4; ++sp) kfB[sp] = kfA[sp];
#pragma unroll
        for (int dd = 0; dd < 2; ++dd) { vfB[dd][0] = vfA[dd][0]; vfB[dd][1] = vfA[dd][1]; }
#pragma unroll
        for (int g = 0; g < 4; ++g) fsB[g] = fsA[g];
        if (nxt >= 0) {
            load_q(kfB, kb + (size_t)nxt * 32 * 64);
            load_v(vfB, vb + nxt * 32);
            if (MODE == 3) {
#pragma unroll
                for (int g = 0; g < 4; ++g) fsB[g] = *(const f32x4*)(Fb + nxt * 32 + 16 * (g >> 1) + 8 * h + 4 * (g & 1));
            }
        }
        const f32x16 x = qk_tile(kfA, qf);
        const bool diag = (tau == qt);
        float p[16];
        if (MODE == 1) {
            float sp_[16];
#pragma unroll
            for (int i = 0; i < 16; ++i) {
                const float z = x[i];
                sp_[i] = fmaxf(z, 0.f) + LN2 * lg2(1.0f + ex2(-fabsf(z) * LOG2E));
            }
            if (diag) {
#pragma unroll
                for (int i = 0; i < 16; ++i) if (!(kidx(i, h) < r)) sp_[i] = 0.f;
            }
            float sfx[16], T[2], bT[2];
#pragma unroll
            for (int o = 0; o < 2; ++o) {
                sfx[8 * o + 7] = sp_[8 * o + 7];
#pragma unroll
                for (int e = 6; e >= 0; --e) sfx[8 * o + e] = sp_[8 * o + e] + sfx[8 * o + e + 1];
                T[o] = sfx[8 * o];
                bT[o] = shx<32>(T[o]);
            }
            float off[2];
            off[1] = R + (h == 0 ? bT[1] : 0.f);
            off[0] = R + (T[1] + bT[1]) + (h == 0 ? bT[0] : 0.f);
            R = R + (T[1] + bT[1]) + (T[0] + bT[0]);
#pragma unroll
            for (int i = 0; i < 16; ++i) {
                const float c = off[i >> 3] + sfx[i];
                p[i] = ex2((x[i] - c) * LOG2E);
            }
            if (diag) {
#pragma unroll
                for (int i = 0; i < 16; ++i) if (!(kidx(i, h) < r)) p[i] = 0.f;
            }
        } else if (MODE == 2) {
            const int nb = tau >> 3;
            const bool own = (nb == qblk);
            const bool lane_ok = own || ((sel >> nb) & 1u);
#pragma unroll
            for (int i = 0; i < 16; ++i) {
                float v = ex2(fmaf(x[i], LOG2E, mb2));
                if (!lane_ok || (diag && kidx(i, h) > r)) v = 0.f;
                p[i] = v; l += v;
            }
        } else {
#pragma unroll
            for (int i = 0; i < 16; ++i) {
                const float dF = ft - fsA[i >> 2][i & 3];
                float v = ex2(fmaf(x[i], LOG2E, (dF - Mb) * LOG2E));
                if (diag && kidx(i, h) > r) v = 0.f;
                p[i] = v; l += v;
            }
        }
        pv_tile(o0, o1, vfA, p);
        if (MODE == 1) { if (__ballot(R < 104.0f) == 0ull) nxt = -1; }
#pragma unroll
        for (int sp = 0; sp < 4; ++sp) kfA[sp] = kfB[sp];
#pragma unroll
        for (int dd = 0; dd < 2; ++dd) { vfA[dd][0] = vfB[dd][0]; vfA[dd][1] = vfB[dd][1]; }
#pragma unroll
        for (int g = 0; g < 4; ++g) fsA[g] = fsB[g];
        tau = nxt;
    }
    float inv = 1.0f;
    if (MODE != 1) { l += shx<32>(l); inv = 1.0f / l; }
    store_y(o0, o1, inv, G, Y, (size_t)(bh >> 3) * S + t, mixer * 512 + (bh & 7) * 64, h);
}

constexpr int AW_K = 0, AW_V = 9216, AW_F = 9216 + 9216, AW_BUF = 9216 + 9216 + 256;
DI unsigned moba_select(const float* KMPb, const bf16x8 (&qf)[4], int qblk, int r, int h) {
    unsigned sel = 0u;
    if (qblk > 0) {
        f32x16 gx;
#pragma unroll
        for (int i = 0; i < 16; ++i) gx[i] = 0.f;
#pragma unroll
        for (int sp = 0; sp < 4; ++sp) {
            const float* kp = KMPb + (size_t)(r * 2) * 64 + 16 * sp + 8 * h;
            const f32x4 a0 = *(const f32x4*)kp, a1 = *(const f32x4*)(kp + 4), b0 = *(const f32x4*)(kp + 64), b1 = *(const f32x4*)(kp + 68);
            f32x8 km, hi_f;
#pragma unroll
            for (int e = 0; e < 4; ++e) { km[e] = (a0[e] + b0[e]) * (1.0f / 256.0f); km[4 + e] = (a1[e] + b1[e]) * (1.0f / 256.0f); }
            const bf16x8 hi = pack8(km);
#pragma unroll
            for (int e = 0; e < 8; ++e) hi_f[e] = km[e] - bf2f((unsigned short)hi[e]);
            const bf16x8 lo = pack8(hi_f);
            gx = mfma32(hi, qf[sp], gx); gx = mfma32(lo, qf[sp], gx);
        }
        const float NEGI = -__builtin_inff();
#pragma unroll
        for (int i = 0; i < 16; ++i) if (crow(i, h) >= qblk) gx[i] = NEGI;
#pragma unroll
        for (int it = 0; it < 3; ++it) {
            float bv = NEGI; int bn = 64;
#pragma unroll
            for (int i = 0; i < 16; ++i) if (gx[i] > bv) { bv = gx[i]; bn = crow(i, h); }
            const float pv = shx<32>(bv); const int pn = shxi<32>(bn);
            if (pv > bv || (pv == bv && pn < bn)) { bv = pv; bn = pn; }
            if (bv > NEGI) sel |= 1u << bn;
#pragma unroll
            for (int i = 0; i < 16; ++i) if (crow(i, h) == bn) gx[i] = NEGI;
        }
    }
    return sel;
}
DI unsigned wave_or(unsigned v) { v |= (unsigned)shxi<1>((int)v); v |= (unsigned)shxi<2>((int)v); v |= (unsigned)shxi<4>((int)v); v |= (unsigned)shxi<8>((int)v); v |= (unsigned)shxi<16>((int)v); v |= (unsigned)shxi<32>((int)v); return v; }

template <int MODE>
DI void sub_tile(const bf16x8 (&kf)[4], const bf16x8 (&vf)[2][2], const bf16x8 (&qf)[4], f32x16& o0, f32x16& o1, float& l, bool diag, float offs, float fm, const LAS float* fsp, int r, int h) {
    f32x16 x;
    float p[16];
    if (MODE == 2) {
#pragma unroll
        for (int i = 0; i < 16; ++i) x[i] = offs;
#pragma unroll
        for (int sp = 0; sp < 4; ++sp) x = mfma32(kf[sp], qf[sp], x);
#pragma unroll
        for (int i = 0; i < 16; ++i) p[i] = ex2(x[i]);
    } else {
        x = qk_tile(kf, qf);
#pragma unroll
        for (int g = 0; g < 4; ++g) {
            const f32x4 fs = *(const LAS f32x4*)(fsp + 16 * (g >> 1) + 8 * h + 4 * (g & 1));
#pragma unroll
            for (int e = 0; e < 4; ++e) p[4 * g + e] = ex2(x[4 * g + e] + (fm - fs[e]));
        }
    }
    if (diag) {
#pragma unroll
        for (int i = 0; i < 16; ++i) if (kidx(i, h) > r) p[i] = 0.f;
    }
#pragma unroll
    for (int i = 0; i < 16; ++i) l += p[i];
    pv_tile(o0, o1, vf, p);
}

template <int MODE>
DI void attn_wg2_item(const bf16_t* Qm, const bf16_t* Km, const bf16_t* Vtm, const float* Fb, const float* KMPb, const bf16_t* G, bf16_t* Y, int bh, int qb2, int halfq, int mixer, float Mb, LAS unsigned char* lds, int tid, int wave, int lane) {
    asm volatile("" : "+v"(tid), "+v"(lane));
    const int r = lane & 31, h = lane >> 5;
    const int qtA = halfq ? qb2 * 8 + wave : qb2 * 16 + wave, qtB = halfq ? -1 : qb2 * 16 + 15 - wave, tA = qtA * 32 + r, tB = halfq ? tA : qtB * 32 + r;
    bf16x8 qfA[4], qfB[4];
    load_q(qfA, Qm + ((size_t)bh * S + tA) * 64 + 8 * h);
    load_q(qfB, Qm + ((size_t)bh * S + tB) * 64 + 8 * h);
    const int qblkA = qtA >> 3, qblkB = halfq ? 0 : (qtB >> 3);
    unsigned selA = 0u, selB = 0u, visA = 0xffffffffu, visB = 0xffffffffu;
    float fmA = 0.f, fmB = 0.f, Ft0 = 0.f;
    if (MODE == 3) { fmA = (Fb[tA] - Mb) * LOG2E; fmB = (Fb[tB] - Mb) * LOG2E; Ft0 = Fb[halfq ? qb2 * 256 : qb2 * 512]; }
    if (MODE == 2) {
        selA = moba_select(KMPb, qfA, qblkA, r, h); selB = halfq ? 0u : moba_select(KMPb, qfB, qblkB, r, h);
        visA = wave_or(selA) | (1u << qblkA); visB = wave_or(selB) | (1u << qblkB);
    }
    f32x16 oA0, oA1, oB0, oB1;
#pragma unroll
    for (int i = 0; i < 16; ++i) { oA0[i] = 0.f; oA1[i] = 0.f; oB0[i] = 0.f; oB1[i] = 0.f; }
    float lA = 0.f, lB = 0.f;
    const float mb2 = -Mb * LOG2E, NEGI = -__builtin_inff();
    const int srow = tid >> 3, sch = tid & 7;
    const bf16_t* kg = Km + ((size_t)bh * S + srow) * 64 + sch * 8;
    const bf16_t* vg = Vtm + ((size_t)bh * 64 + srow) * S + sch * 8;
    const unsigned kws = AW_K + srow * 144 + sch * 16, vws = AW_V + srow * 144 + sch * 16;
    const unsigned kra = AW_K + kperm(r) * 144 + 16 * h, vra = AW_V + r * 144 + 16 * h;
    int cur = halfq ? qb2 * 4 + 3 : qb2 * 8 + 7, buf = 0;
    {
        const bf16x8 kreg = *(const bf16x8*)(kg + (size_t)cur * 4096);
        const u32x4 vreg = *(const u32x4*)(vg + cur * 64);
        *(LAS bf16x8*)(lds + kws) = kreg;
        *(LAS u32x4*)(lds + vws) = vreg;
        if (MODE == 3 && tid < 16) *(LAS f32x4*)(lds + AW_F + tid * 16) = *(const f32x4*)(Fb + cur * 64 + tid * 4) * LOG2E;
    }
    __syncthreads();
    while (cur >= 0) {
        int nxt = cur - 1;
        if (MODE == 3) { if (nxt >= 0) { const float fk = Fb[nxt * 64 + 63]; if ((Ft0 - fk) + 2.0f * Mb < -104.0f) nxt = -1; } }
        nxt = __builtin_amdgcn_readfirstlane(nxt);
        bf16x8 kreg; u32x4 vreg; f32x4 freg;
#pragma unroll
        for (int e = 0; e < 8; ++e) kreg[e] = 0;
        vreg = (u32x4){0u, 0u, 0u, 0u}; freg = (f32x4){0.f, 0.f, 0.f, 0.f};
        if (nxt >= 0) {
            kreg = *(const bf16x8*)(kg + (size_t)nxt * 4096);
            vreg = *(const u32x4*)(vg + nxt * 64);
            if (MODE == 3 && tid < 16) freg = *(const f32x4*)(Fb + nxt * 64 + tid * 4);
        }
        LAS unsigned char* lb = lds + buf * AW_BUF;
#pragma unroll
        for (int kk = 1; kk >= 0; --kk) {
            const int tau = cur * 2 + kk, nb = tau >> 3;
            bool actA = tau <= qtA, actB = tau <= qtB;
            if (MODE == 2) { actA = actA && ((visA >> nb) & 1u); actB = actB && ((visB >> nb) & 1u); }
            if (actA || actB) {
                bf16x8 kf[4], vf[2][2];
#pragma unroll
                for (int sp = 0; sp < 4; ++sp) kf[sp] = *(LAS bf16x8*)(lb + kra + kk * 32 * 144 + sp * 32);
#pragma unroll
                for (int dd = 0; dd < 2; ++dd)
#pragma unroll
                    for (int s = 0; s < 2; ++s) vf[dd][s] = *(LAS bf16x8*)(lb + vra + dd * 32 * 144 + kk * 64 + s * 32);
                float offA = mb2, offB = mb2;
                if (MODE == 2) { offA = ((nb == qblkA) || ((selA >> nb) & 1u)) ? mb2 : NEGI; offB = ((nb == qblkB) || ((selB >> nb) & 1u)) ? mb2 : NEGI; }
                const LAS float* fsp = (const LAS float*)(lb + AW_F) + kk * 32;
                if (actA) sub_tile<MODE>(kf, vf, qfA, oA0, oA1, lA, tau == qtA, offA, fmA, fsp, r, h);
                if (actB) sub_tile<MODE>(kf, vf, qfB, oB0, oB1, lB, tau == qtB, offB, fmB, fsp, r, h);
            }
        }
        if (nxt >= 0) {
            LAS unsigned char* nb_ = lds + (buf ^ 1) * AW_BUF;
            *(LAS bf16x8*)(nb_ + kws) = kreg;
            *(LAS u32x4*)(nb_ + vws) = vreg;
            if (MODE == 3 && tid < 16) *(LAS f32x4*)(nb_ + AW_F + tid * 16) = freg * LOG2E;
        }
        __syncthreads();
        buf ^= 1; cur = nxt;
    }
    lA += shx<32>(lA); lB += shx<32>(lB);
    store_y(oA0, oA1, 1.0f / lA, G, Y, (size_t)(bh >> 3) * S + tA, mixer * 512 + (bh & 7) * 64, h);
    if (!halfq) store_y(oB0, oB1, 1.0f / lB, G, Y, (size_t)(bh >> 3) * S + tB, mixer * 512 + (bh & 7) * 64, h);
}

DI void sub_tile_sb(const bf16x8 (&kf)[4], const bf16x8 (&vf)[2][2], const bf16x8 (&qf)[4], f32x16& o0, f32x16& o1, float& R, bool diag, int r, int h) {
    const f32x16 x = qk_tile(kf, qf);
    float sp_[16], p[16];
#pragma unroll
    for (int e = 0; e < 16; ++e) { const float z = x[e]; sp_[e] = fmaxf(z, 0.f) + LN2 * lg2(1.0f + ex2(-fabsf(z) * LOG2E)); }
    if (diag) {
#pragma unroll
        for (int e = 0; e < 16; ++e) if (!(kidx(e, h) < r)) sp_[e] = 0.f;
    }
    float sfx[16], T[2], bT[2];
#pragma unroll
    for (int o = 0; o < 2; ++o) {
        sfx[8 * o + 7] = sp_[8 * o + 7];
#pragma unroll
        for (int e = 6; e >= 0; --e) sfx[8 * o + e] = sp_[8 * o + e] + sfx[8 * o + e + 1];
        T[o] = sfx[8 * o];
        bT[o] = shx<32>(T[o]);
    }
    float off[2];
    off[1] = R + (h == 0 ? bT[1] : 0.f);
    off[0] = R + (T[1] + bT[1]) + (h == 0 ? bT[0] : 0.f);
    R = R + (T[1] + bT[1]) + (T[0] + bT[0]);
#pragma unroll
    for (int e = 0; e < 16; ++e) p[e] = ex2((x[e] - (off[e >> 3] + sfx[e])) * LOG2E);
    if (diag) {
#pragma unroll
        for (int e = 0; e < 16; ++e) if (!(kidx(e, h) < r)) p[e] = 0.f;
    }
    pv_tile(o0, o1, vf, p);
}
DI void attn_wgB_item(const bf16_t* Qm, const bf16_t* Km, const bf16_t* Vtm, const bf16_t* G, bf16_t* Y, int bh, int qb2, int halfq, LAS unsigned char* lds, int tid, int wave, int lane) {
    asm volatile("" : "+v"(tid), "+v"(lane));
    const int r = lane & 31, h = lane >> 5;
    const int qtA = halfq ? qb2 * 8 + wave : qb2 * 16 + wave, qtB = halfq ? -1 : qb2 * 16 + 15 - wave, tA = qtA * 32 + r, tB = halfq ? tA : qtB * 32 + r;
    bf16x8 qfA[4], qfB[4];
    load_q(qfA, Qm + ((size_t)bh * S + tA) * 64 + 8 * h);
    load_q(qfB, Qm + ((size_t)bh * S + tB) * 64 + 8 * h);
    f32x16 oA0, oA1, oB0, oB1;
#pragma unroll
    for (int i = 0; i < 16; ++i) { oA0[i] = 0.f; oA1[i] = 0.f; oB0[i] = 0.f; oB1[i] = 0.f; }
    float RA = 0.f, RB = 0.f;
    bool doneA = false, doneB = (halfq != 0);
    const int srow = tid >> 3, sch = tid & 7;
    const bf16_t* kg = Km + ((size_t)bh * S + srow) * 64 + sch * 8;
    const bf16_t* vg = Vtm + ((size_t)bh * 64 + srow) * S + sch * 8;
    const unsigned kws = AW_K + srow * 144 + sch * 16, vws = AW_V + srow * 144 + sch * 16;
    const unsigned kra = AW_K + kperm(r) * 144 + 16 * h, vra = AW_V + r * 144 + 16 * h;
    LAS int* fl = (LAS int*)(lds + 2 * AW_BUF);
    int cur = halfq ? qb2 * 4 + 3 : qb2 * 8 + 7, buf = 0, it = 0;
    {
        const bf16x8 kreg = *(const bf16x8*)(kg + (size_t)cur * 4096);
        const u32x4 vreg = *(const u32x4*)(vg + cur * 64);
        *(LAS bf16x8*)(lds + kws) = kreg;
        *(LAS u32x4*)(lds + vws) = vreg;
    }
    __syncthreads();
    while (cur >= 0) {
        int nxt = cur - 1;
        bf16x8 kreg; u32x4 vreg;
#pragma unroll
        for (int e = 0; e < 8; ++e) kreg[e] = 0;
        vreg = (u32x4){0u, 0u, 0u, 0u};
        if (nxt >= 0) {
            kreg = *(const bf16x8*)(kg + (size_t)nxt * 4096);
            vreg = *(const u32x4*)(vg + nxt * 64);
        }
        LAS unsigned char* lb = lds + buf * AW_BUF;
#pragma unroll
        for (int kk = 1; kk >= 0; --kk) {
            const int tau = cur * 2 + kk;
            const bool actA = (tau <= qtA) && !doneA, actB = (tau <= qtB) && !doneB;
            if (actA || actB) {
                bf16x8 kf[4], vf[2][2];
#pragma unroll
                for (int sp = 0; sp < 4; ++sp) kf[sp] = *(LAS bf16x8*)(lb + kra + kk * 32 * 144 + sp * 32);
#pragma unroll
                for (int dd = 0; dd < 2; ++dd)
#pragma unroll
                    for (int s = 0; s < 2; ++s) vf[dd][s] = *(LAS bf16x8*)(lb + vra + dd * 32 * 144 + kk * 64 + s * 32);
                if (actA) { sub_tile_sb(kf, vf, qfA, oA0, oA1, RA, tau == qtA, r, h); if (__ballot(RA < 104.0f) == 0ull) doneA = true; }
                if (actB) { sub_tile_sb(kf, vf, qfB, oB0, oB1, RB, tau == qtB, r, h); if (__ballot(RB < 104.0f) == 0ull) doneB = true; }
            }
        }
        if (nxt >= 0) {
            LAS unsigned char* nb_ = lds + (buf ^ 1) * AW_BUF;
            *(LAS bf16x8*)(nb_ + kws) = kreg;
            *(LAS u32x4*)(nb_ + vws) = vreg;
        }
        if (lane == 0) fl[(it & 1) * 8 + wave] = (doneA && doneB) ? 1 : 0;
        __syncthreads();
        int all = 1;
#pragma unroll
        for (int w = 0; w < 8; ++w) all &= fl[(it & 1) * 8 + w];
        if (__builtin_amdgcn_readfirstlane(all)) nxt = -1;
        buf ^= 1; cur = nxt; ++it;
    }
    store_y(oA0, oA1, 1.0f, G, Y, (size_t)(bh >> 3) * S + tA, 1 * 512 + (bh & 7) * 64, h);
    if (!halfq) store_y(oB0, oB1, 1.0f, G, Y, (size_t)(bh >> 3) * S + tB, 1 * 512 + (bh & 7) * 64, h);
}

DI void attn_A_item(const bf16_t* Q0, const bf16_t* K0, const bf16_t* VT0, const bf16_t* VTXp, const bf16_t* G, bf16_t* Y, int bh, int blk, float Mb, LAS float* Oacc, LAS float* lacc, int tid, int wave, int lane) {
    asm volatile("" : "+v"(tid), "+v"(lane));
    const int r = lane & 31, h = lane >> 5, t0 = blk * 512;
    {
        LAS f32x4* row = (LAS f32x4*)(Oacc + tid * 68);
#pragma unroll
        for (int i = 0; i < 17; ++i) row[i] = (f32x4){0.f, 0.f, 0.f, 0.f};
        lacc[tid] = 0.f;
    }
    __syncthreads();
    const float mb2 = -Mb * LOG2E;
#pragma unroll 1
    for (int seg = 0; seg < 3; ++seg) {
        const int sh = 2 * seg, L = S >> sh;
        const bf16_t* Vs = (seg == 0) ? (VT0 + (size_t)bh * 64 * S) : (VTXp + (size_t)((seg - 1) * 16 + bh) * 64 * S);
#pragma unroll 1
        for (int jq = 0; jq < 2; ++jq) {
            const int j = 2 * wave + jq, tpr = 16 >> sh, res = j / tpr, jj = j % tpr, m0 = (t0 >> sh) + 32 * jj;
            const int t = ((m0 + r) << sh) + res;
            bf16x8 qf[4];
            load_q(qf, Q0 + ((size_t)bh * S + t) * 64 + 8 * h);
            f32x16 o0, o1;
#pragma unroll
            for (int i = 0; i < 16; ++i) { o0[i] = 0.f; o1[i] = 0.f; }
            float l = 0.f;
            const int kfirst = m0 - 128;
            const float NEGI = -__builtin_inff();
            bf16x8 kf[5][4];
#pragma unroll
            for (int i = 0; i < 5; ++i) {
                const int kt = kfirst + 32 * i, ktc = kt < 0 ? 0 : kt;
                load_q(kf[i], K0 + ((size_t)bh * S + (((ktc + uperm(kperm(r), seg == 1)) << sh) + res)) * 64 + 8 * h);
            }
            f32x16 xs[5];
#pragma unroll
            for (int i = 0; i < 5; ++i) {
                const float offs = (kfirst + 32 * i < 0) ? NEGI : mb2;
#pragma unroll
                for (int e = 0; e < 16; ++e) xs[i][e] = offs;
#pragma unroll
                for (int sp = 0; sp < 4; ++sp) xs[i] = mfma32(kf[i][sp], qf[sp], xs[i]);
            }
#pragma unroll
            for (int i = 0; i < 5; ++i) {
                const int kt = kfirst + 32 * i, ktc = kt < 0 ? 0 : kt;
                bf16x8 vf[2][2];
                load_v(vf, Vs + (size_t)r * S + (size_t)res * L + ktc + 8 * h);
                float p[16];
#pragma unroll
                for (int e = 0; e < 16; ++e) {
                    float v = ex2(xs[i][e]);
                    const int c = uperm(kidx(e, h), seg == 1);
                    if ((i == 0 && c < r) || (i == 4 && c > r)) v = 0.f;
                    p[e] = v;
                }
#pragma unroll
                for (int e = 0; e < 16; ++e) l += p[e];
                pv_tile(o0, o1, vf, p);
            }
            l += shx<32>(l);
            const int tl = t - t0;
#pragma unroll
            for (int dd = 0; dd < 2; ++dd)
#pragma unroll
                for (int g = 0; g < 4; ++g) {
                    LAS f32x4* pp = (LAS f32x4*)(Oacc + tl * 68 + 32 * dd + 8 * g + 4 * h);
                    f32x4 cur = *pp;
#pragma unroll
                    for (int e = 0; e < 4; ++e) cur[e] += (dd == 0 ? o0[4 * g + e] : o1[4 * g + e]);
                    *pp = cur;
                }
            if (h == 0) lacc[tl] += l;
        }
        __syncthreads();
    }
    {
        const int t = t0 + tid; const size_t row = (size_t)(bh >> 3) * S + t; const int col0 = (bh & 7) * 64;
        const float inv = 1.0f / lacc[tid];
#pragma unroll
        for (int c8 = 0; c8 < 8; ++c8) {
            const f32x4 a0 = *(LAS f32x4*)(Oacc + tid * 68 + 8 * c8), a1 = *(LAS f32x4*)(Oacc + tid * 68 + 8 * c8 + 4);
            const bf16x8 gt = *(const bf16x8*)(G + row * DM + col0 + 8 * c8);
            f32x8 o;
#pragma unroll
            for (int e = 0; e < 4; ++e) { o[e] = a0[e] * inv * bf2f((unsigned short)gt[e]); o[4 + e] = a1[e] * inv * bf2f((unsigned short)gt[4 + e]); }
            *(bf16x8*)(Y + row * DM + col0 + 8 * c8) = pack8(o);
        }
    }
    __syncthreads();
}

#define XB_TMO      128
#define XB_XCNT(j)  (256  + 64 * (j))
#define XB_XSUB(j)  (1280 + 64 * (j))
#define XB_XGEN(j)  (2304 + 64 * (j))
#define XB_TOP      3328
#define XB_TOPGEN   3392
#define XCD_BAR_WORDS 3456
#define XB_SPIN_CAP (1u << 18)

__device__ __forceinline__ unsigned xb_ld(unsigned* p)              { return __hip_atomic_load(p, __ATOMIC_RELAXED, __HIP_MEMORY_SCOPE_AGENT); }
__device__ __forceinline__ unsigned xb_add(unsigned* p, unsigned v) { return __hip_atomic_fetch_add(p, v, __ATOMIC_RELAXED, __HIP_MEMORY_SCOPE_AGENT); }
__device__ __forceinline__ unsigned xb_xcc_id() { return (unsigned)__builtin_amdgcn_s_getreg((3 << 11) | 20) & 0xFu; }
#define XB_SPIN(cond, bar) do { unsigned _sp = 0; while (cond) { __builtin_amdgcn_s_sleep(1); \
    if ((++_sp & 255u) == 0u) { if (xb_ld(&(bar)[XB_TMO])) break; if (_sp > XB_SPIN_CAP) { atomicAdd(&(bar)[XB_TMO], 1u); break; } } } } while (0)

struct XcdBarrier {
    unsigned* bar; unsigned x;
    volatile LAS unsigned* st;
};

__device__ __forceinline__ XcdBarrier xcd_barrier_post(unsigned* bar, volatile LAS unsigned* st) {
    XcdBarrier b; b.bar = bar; b.x = xb_xcc_id(); b.st = st;
    if (threadIdx.x == 0) (void)xb_add(&bar[XB_XCNT(b.x)], 1u);
    return b;
}
__device__ __forceinline__ void xcd_barrier_complete(unsigned* bar, unsigned x, unsigned& nloc, unsigned& nx) {
    const unsigned G = gridDim.x * gridDim.y * gridDim.z;
    unsigned sum, cnt, mine, sp = 0u;
    for (;;) {
        sum = 0u; cnt = 0u; mine = 0u;
#pragma unroll
        for (unsigned j = 0; j < 16; ++j) { const unsigned c = xb_ld(&bar[XB_XCNT(j)]); sum += c; cnt += (c > 0u) ? 1u : 0u; mine = (j == x) ? c : mine; }
        if (sum == G) break;
        __builtin_amdgcn_s_sleep(1);
        if ((++sp & 255u) == 0u) { if (xb_ld(&bar[XB_TMO])) break; if (sp > XB_SPIN_CAP) { atomicAdd(&bar[XB_TMO], 1u); break; } }
    }
    nloc = mine > 0u ? mine : 1u; nx = cnt > 0u ? cnt : 1u;
}

__device__ __forceinline__ void xcd_barrier(const XcdBarrier& b) {
    asm volatile("s_waitcnt vmcnt(0)" ::: "memory");
    __syncthreads();
    if (threadIdx.x == 0) {
        unsigned* bar = b.bar;
        __builtin_amdgcn_s_waitcnt(0);
        unsigned nloc = b.st[0], nx = b.st[1];
        if (nloc == 0u) { xcd_barrier_complete(bar, b.x, nloc, nx); b.st[0] = nloc; b.st[1] = nx; }
        const unsigned old = xb_add(&bar[XB_XSUB(b.x)], 1u);
        const unsigned gen = old / nloc;
        if (old + 1u == (gen + 1u) * nloc) {
            __builtin_amdgcn_fence(__ATOMIC_RELEASE, "agent");
            asm volatile("s_waitcnt vmcnt(0)" ::: "memory");
            const unsigned og = xb_add(&bar[XB_TOP], 1u);
            const unsigned tg = og / nx;
            if (og + 1u == (tg + 1u) * nx) xb_add(&bar[XB_TOPGEN], 1u);
            else XB_SPIN(xb_ld(&bar[XB_TOPGEN]) == tg, bar);
            __builtin_amdgcn_fence(__ATOMIC_ACQUIRE, "agent");
            xb_add(&bar[XB_XGEN(b.x)], 1u);
            asm volatile("s_waitcnt vmcnt(0)" ::: "memory");
        } else {
            XB_SPIN(xb_ld(&bar[XB_XGEN(b.x)]) == gen, bar);
            __builtin_amdgcn_fence(__ATOMIC_ACQUIRE, "agent");
            asm volatile("s_waitcnt vmcnt(0)" ::: "memory");
        }
    }
    __syncthreads();
}

#ifndef REP_A
#define REP_A 1
#endif
#ifndef REP_CD
#define REP_CD 1
#endif
#ifndef REP_B
#define REP_B 1
#endif
#ifndef REP_G1
#define REP_G1 1
#endif
#ifndef REP_G2
#define REP_G2 1
#endif
#ifndef REP_N
#define REP_N 1
#endif
#ifndef REP_P
#define REP_P 1
#endif
__global__ void __launch_bounds__(512, 2) mega_fwd(Args a) {
    extern __shared__ __attribute__((aligned(16))) unsigned char lds_raw[];
    LAS unsigned char* lds = (LAS unsigned char*)lds_raw;
    cg::grid_group grid = cg::this_grid();
    if (threadIdx.x == 0) { ((volatile LAS unsigned*)(lds + 147300))[0] = 0u; ((volatile LAS unsigned*)(lds + 147300))[1] = 0u; }
    __syncthreads();
    (void)xcd_barrier_post((unsigned*)(a.ws + WS_CTL) + 12288, (volatile LAS unsigned*)(lds + 147300));
#define GSYNC() do { const __attribute__((address_space(4))) Args* ap2 = (const __attribute__((address_space(4))) Args*)__builtin_amdgcn_kernarg_segment_ptr(); asm volatile("" : "+s"(ap2)); \
        XcdBarrier xb_; xb_.bar = (unsigned*)(ap2->ws + WS_CTL) + 12288; xb_.x = xb_xcc_id(); xb_.st = (volatile LAS unsigned*)(lds + 147300); xcd_barrier(xb_); } while (0)
#define WSP(T, off) ((T*)(ws + (off)))
#define OPAQUE_WS const __attribute__((address_space(4))) Args* ap = (const __attribute__((address_space(4))) Args*)__builtin_amdgcn_kernarg_segment_ptr(); asm volatile("" : "+s"(ap)); unsigned char* ws = ap->ws; int tid = threadIdx.x; asm volatile("" : "+v"(tid)); const int lane = tid & 63, wave = __builtin_amdgcn_readfirstlane(tid >> 6); int G = gridDim.x; asm volatile("" : "+s"(G)); const int gw = blockIdx.x * 8 + wave, NGW = G * 8; (void)lane; (void)wave; (void)gw; (void)NGW
    {
        OPAQUE_WS;
        bf16_t* WinT = WSP(bf16_t, WS_WIN); bf16_t* WoutT = WSP(bf16_t, WS_WOUT); float* COS = WSP(float, WS_COS); float* SIN = WSP(float, WS_SIN);
        LAS float* scr = (LAS float*)(lds + wave * 16384);
        constexpr int I_IN = 32 * 256, I_OUT = 32 * 64, I_L = I_IN + I_OUT;
        for (int rep = 0; rep < REP_P; ++rep)
        for (int it = gw; it < NL * I_L; it += NGW) {
            const int l = it / I_L; int rr = it % I_L;
            if (rr < I_IN) {
                const int kbk = rr >> 8, nbk = rr & 255, n0 = 32 * nbk;
                const int pns = n0 >> 8, mxs = (pns & 7) >> 1, pnd = (pns & ~7) | ((((mxs & 1) << 1) | (mxs >> 1)) << 1) | (pns & 1);
                const int nd = pnd * 256 + 128 * ((n0 >> 5) & 1) + 32 * ((n0 >> 6) & 3);
                transpose_item(ap->w_in + (size_t)l * DM * NCOL, NCOL, ap->ng + l * DM, WinT + (size_t)l * NPROJ * DM, DM, 64 * kbk, n0, nd, scr, lane);
            } else {
                rr -= I_IN; const int kbk = rr >> 6, nbk = rr & 63;
                transpose_item(ap->w_out + (size_t)l * DM * DM, DM, nullptr, WoutT + (size_t)l * DM * DM, DM, 64 * kbk, 32 * nbk, 32 * nbk, scr, lane);
            }
        }
        {
            float* WF = WSP(float, WS_WF);
            for (int e = blockIdx.x * 512 + tid; e < NL * 4096; e += G * 512) {
                const int l = e >> 12, q = e & 4095, ln = q & 63, hh = (q >> 6) & 1, je = q >> 7, d = 256 * (je >> 2) + 4 * ln + (je & 3);
                const float g = ap->ng[l * DM + d];
                const f32x4 w = *(const f32x4*)(ap->w_in + (size_t)l * DM * NCOL + (size_t)d * NCOL + NPROJ + 4 * hh);
                ((f32x4*)WF)[e] = w * g;
            }
        }
        for (int e = blockIdx.x * 512 + tid; e < S * 32; e += G * 512) {
            const int pos = e >> 5, j = e & 31;
            const float ang = (float)pos * ap->inv_freq[j];
            const double rev = (double)ang * 0.15915494309189535;
            const float fr = (float)(rev - floor(rev));
            COS[e] = __builtin_amdgcn_cosf(fr); SIN[e] = __builtin_amdgcn_sinf(fr);
        }
    }

#pragma unroll 1
    for (int l = 0; l < NL; ++l) {
        {
            OPAQUE_WS;
            bf16_t* XB = WSP(bf16_t, WS_XB); float* LOGF = WSP(float, WS_LOGF);
            const float* src = (l == 0) ? ap->x : ap->out;
            if (l == 0) grid.sync();
            {
                const f32x4* WFg = (const f32x4*)WSP(float, WS_WF) + (size_t)l * 4096;
                LAS f32x4* wfl = (LAS f32x4*)lds;
#pragma unroll
                for (int i = 0; i < 8; ++i) wfl[tid + 512 * i] = WFg[tid + 512 * i];
                __syncthreads();
            }
            for (int rep = 0; rep < REP_N; ++rep)
            for (int m = gw; m < MT; m += NGW) {
                const int b = m / S, s = m % S;
                norm_row(src + (size_t)m * DM, (const LAS f32x4*)lds, ap->fb + l * 8, XB + (size_t)m * DM, LOGF + (size_t)b * 8 * S, s, lane);
            }
        }
        GSYNC();
        if (blockIdx.x < 16) {
            OPAQUE_WS;
            float* LOGF = WSP(float, WS_LOGF); float* FB = WSP(float, WS_F);
            const int bh = blockIdx.x;
            const float* lf = LOGF + (size_t)bh * S + tid * 16;
            float v[16];
#pragma unroll
            for (int i = 0; i < 4; ++i) { const f32x4 t = ((const f32x4*)lf)[i]; v[4 * i] = t[0]; v[4 * i + 1] = t[1]; v[4 * i + 2] = t[2]; v[4 * i + 3] = t[3]; }
            double tot = 0.0;
#pragma unroll
            for (int i = 0; i < 16; ++i) tot += (double)v[i];
            double inc = tot;
#pragma unroll
            for (int o = 1; o < 64; o <<= 1) { const double t = __shfl_up(inc, o); if (lane >= o) inc += t; }
            LAS double* wt = (LAS double*)lds;
            if (lane == 63) wt[wave] = inc;
            __syncthreads();
            double base = inc - tot;
            for (int w = 0; w < wave; ++w) base += wt[w];
            float* fo = FB + (size_t)bh * S + tid * 16;
            double run = base;
#pragma unroll
            for (int i = 0; i < 4; ++i) { f32x4 t; for (int e = 0; e < 4; ++e) { run += (double)v[4 * i + e]; t[e] = (float)run; } ((f32x4*)fo)[i] = t; }
            __syncthreads();
        }
        {
            OPAQUE_WS;
            bf16_t* WinT = WSP(bf16_t, WS_WIN); bf16_t* XB = WSP(bf16_t, WS_XB); bf16_t* Qb = WSP(bf16_t, WS_Q); bf16_t* Kb = WSP(bf16_t, WS_K); bf16_t* VT = WSP(bf16_t, WS_VT); bf16_t* VTX = WSP(bf16_t, WS_VTX);
            bf16_t* Gb = WSP(bf16_t, WS_G); float* KMP = WSP(float, WS_KMP); float* COS = WSP(float, WS_COS); float* SIN = WSP(float, WS_SIN);
            pg8::Gemm g{XB, WinT + (size_t)l * NPROJ * DM, MT, NPROJ, DM}; pg8::StaticOrder So; So.init(MT, NPROJ, G, (int)blockIdx.x);
            EpiIn E{Qb, Kb, VT, VTX, Gb, KMP, ap->qg + l * 192, ap->kg + l * 192, COS, SIN};
            for (int rep = 0; rep < REP_G1; ++rep) pg8::gemm_phase<EpiIn, pg8::StaticOrder, true, true>(lds, g, So, E);
        }
        GSYNC();
        {
            OPAQUE_WS;
            unsigned* ctl = WSP(unsigned, WS_CTL); bf16_t* Qb = WSP(bf16_t, WS_Q); bf16_t* Kb = WSP(bf16_t, WS_K); bf16_t* VT = WSP(bf16_t, WS_VT); bf16_t* VTX = WSP(bf16_t, WS_VTX);
            bf16_t* Gb = WSP(bf16_t, WS_G); bf16_t* Yb = WSP(bf16_t, WS_Y); float* FB = WSP(float, WS_F); float* KMP = WSP(float, WS_KMP);
            float Mx[3];
#pragma unroll
            for (int gi = 0; gi < 3; ++gi) {
                const float gq = wave_max(fabsf(ap->qg[l * 192 + gi * 64 + lane])), gk = wave_max(fabsf(ap->kg[l * 192 + gi * 64 + lane]));
                Mx[gi] = 8.1f * gq * gk;
            }
            LAS float* Oacc = (LAS float*)lds; LAS float* lacc = (LAS float*)(lds + 512 * 68 * 4);
            const int xcc = (int)(__builtin_amdgcn_s_getreg((3 << 11) | 20) & 7u);
            const int vb = (G == 256) ? ((int)(blockIdx.x & 7) * 32 + (int)(blockIdx.x >> 3)) : (int)blockIdx.x;
            for (int rep = 0; rep < REP_A; ++rep)
            for (int it = vb; it < 256; it += G)
                attn_A_item(Qb, Kb, VT, VTX, Gb, Yb, it >> 4, it & 15, Mx[0], Oacc, lacc, tid, wave, lane);
            for (int rep = 0; rep < REP_CD; ++rep) {
                LAS int* qw = (LAS int*)(lds + 147200);
                for (int sq = 0; sq < 8; ++sq) {
                    const int q = (xcc + sq) & 7;
                    unsigned* ctr = ctl + 64 * (l * 16 + q) + 1024 * 4 * rep;
                    for (;;) {
                        if (tid == 0) *qw = (int)atomicAdd(ctr, 1u);
                        __syncthreads();
                        const int idx = __builtin_amdgcn_readfirstlane(*qw);
                        __syncthreads();
                        if (idx >= 72) break;
                        const int k = idx >> 2, j = idx & 3, bh = 2 * q + (j >> 1), halfq = (k >= 6 && k < 10), qb2 = k < 6 ? 13 - k : (halfq ? 37 - k : 17 - k);
                        if (j & 1) attn_wg2_item<3>(Qb + (size_t)3 * 16 * S * 64, Kb + (size_t)3 * 16 * S * 64, VT + (size_t)3 * 16 * 64 * S, FB + (size_t)bh * S, nullptr, Gb, Yb, bh, qb2, halfq, 3, Mx[2], lds, tid, wave, lane);
                        else attn_wg2_item<2>(Qb + (size_t)2 * 16 * S * 64, Kb + (size_t)2 * 16 * S * 64, VT + (size_t)2 * 16 * 64 * S, nullptr, KMP + (size_t)bh * 32 * 2 * 64, Gb, Yb, bh, qb2, halfq, 2, Mx[1], lds, tid, wave, lane);
                    }
                }
            }
            for (int rep = 0; rep < REP_B; ++rep) {
                LAS int* qw = (LAS int*)(lds + 147200);
                for (int sq = 0; sq < 8; ++sq) {
                    const int q = (xcc + sq) & 7;
                    unsigned* ctr = ctl + 64 * (l * 16 + 8 + q) + 1024 * 4 * rep;
                    for (;;) {
                        if (tid == 0) *qw = (int)atomicAdd(ctr, 1u);
                        __syncthreads();
                        const int idx = __builtin_amdgcn_readfirstlane(*qw);
                        __syncthreads();
                        if (idx >= 64) break;
                        const int qb = 31 - (idx >> 1), bh = 2 * q + (idx & 1);
                        attn_wgB_item(Qb + (size_t)1 * 16 * S * 64, Kb + (size_t)1 * 16 * S * 64, VT + (size_t)1 * 16 * 64 * S, Gb, Yb, bh, qb, 1, lds, tid, wave, lane);
                    }
                }
            }
        }
        GSYNC();
        {
            OPAQUE_WS;
            bf16_t* WoutT = WSP(bf16_t, WS_WOUT); bf16_t* Yb = WSP(bf16_t, WS_Y);
            pg8::Gemm g{Yb, WoutT + (size_t)l * DM * DM, MT, DM, DM}; pg8::StaticOrder So; So.init(MT, DM, G, (int)blockIdx.x);
            EpiOut E{(l == 0) ? ap->x : ap->out, ap->out};
            for (int rep = 0; rep < (REP_G2 > 1 && l == 0 ? REP_G2 : 1); ++rep) pg8::gemm_phase<EpiOut, pg8::StaticOrder, true, true>(lds, g, So, E);
        }
        if (l + 1 < NL) GSYNC();
    }
}

extern "C" void kernel_launch(void* const* d_in, const int* in_sizes, int n_in, void* d_out, int out_size, void* d_ws, size_t ws_size, hipStream_t stream) {
    static int grid = 0;
    if (grid == 0) {
        if (n_in != 7 || out_size != MT * DM || ws_size < WS_END) { fprintf(stderr, "kernel_launch: unexpected shapes (n_in %d out %d ws %zu)\n", n_in, out_size, ws_size); grid = -1; return; }
        int dev = 0, cus = 0, per_cu = 0;
        hipGetDevice(&dev); hipDeviceGetAttribute(&cus, hipDeviceAttributeMultiprocessorCount, dev);
        if (hipFuncSetAttribute((const void*)mega_fwd, hipFuncAttributeMaxDynamicSharedMemorySize, LDS_BYTES) != hipSuccess) { fprintf(stderr, "kernel_launch: hipFuncSetAttribute failed\n"); grid = -1; return; }
        if (hipOccupancyMaxActiveBlocksPerMultiprocessor(&per_cu, (const void*)mega_fwd, 512, LDS_BYTES) != hipSuccess || per_cu < 1) { fprintf(stderr, "kernel_launch: occupancy query says %d\n", per_cu); per_cu = 1; }
        (void)hipGetLastError();
        grid = cus * per_cu;
    }
    if (grid < 0) return;
    hipMemsetAsync((char*)d_ws + WS_CTL, 0, CTL_BYTES, stream);
    Args a{};
    a.x = (const float*)d_in[0]; a.ng = (const float*)d_in[1]; a.w_in = (const float*)d_in[2]; a.qg = (const float*)d_in[3]; a.kg = (const float*)d_in[4];
    a.fb = (const float*)d_in[5]; a.w_out = (const float*)d_in[6]; a.out = (float*)d_out; a.ws = (unsigned char*)d_ws;
    for (int j = 0; j < 32; ++j) a.inv_freq[j] = (float)(1.0 / pow(10000.0, (double)j / 32.0));
    void* args[] = {&a};
    hipError_t e = hipLaunchCooperativeKernel((const void*)mega_fwd, dim3(grid), dim3(512), args, LDS_BYTES, stream);
    if (e != hipSuccess) fprintf(stderr, "kernel_launch: cooperative launch failed: %s (grid %d)\n", hipGetErrorString(e), grid);
}
```

```cpp
#include <hip/hip_runtime.h>
#include <hip/hip_cooperative_groups.h>
#include <cstdio>
#include <cstdint>
#include <cmath>
namespace cg = cooperative_groups;
namespace pg8 {
#define PG8_LAS __attribute__((address_space(3)))
typedef unsigned short bf16_t;
typedef short bf16x8 __attribute__((ext_vector_type(8)));
typedef float f32x4 __attribute__((ext_vector_type(4)));
typedef unsigned u32x4 __attribute__((ext_vector_type(4)));
constexpr int BM = 256, BK = 64, HALF = 128, HTB = HALF * BK * 2  , STAGE_BYTES = 8 * HTB, NXCD = 8, WGM = 8;

__host__ __device__ __forceinline__ int lds_byte(int r, int c) { const int st = (r >> 4) * 2 + (c >> 5), rr = r & 15, cc = c & 31, ob = rr * 64 + cc * 2; return st * 1024 + (ob ^ (((ob >> 9) & 1) << 5)); }
__host__ __device__ __forceinline__ void stage_rc(int b, int& R, int& C) { const int st = b / 1024, sb = b % 1024, swz = sb ^ (((sb >> 9) & 1) << 5); R = (st >> 1) * 16 + swz / 64; C = (st & 1) * 32 + (swz % 64) / 2; }
__host__ __device__ __forceinline__ int perm32(int rho) { const int n = rho >> 4, i = rho & 15; return 8 * (i >> 2) + 4 * n + (i & 3); }

struct Unit { int pm, pn; };
struct Gemm { const bf16_t* A; const bf16_t* Bt; int M, N, K; };

struct StaticOrder {
    int nM, nN, nwg, G, c;
    __host__ __device__ void init(int M, int N, int G_, int c_) { nM = M / BM; nN = N / BM; nwg = nM * nN; G = G_; c = c_; }
    __host__ __device__ bool next(int i, Unit& u) const {
        const long L = (long)i * G + c; if (L >= nwg) return false;
        int wgid = (int)L; { const int q = nwg / NXCD, r = nwg % NXCD, xcd = wgid % NXCD, off = wgid / NXCD; wgid = (xcd < r ? xcd * (q + 1) : r * (q + 1) + (xcd - r) * q) + off; }
        const int nig = WGM * nN, gid = wgid / nig, fm = gid * WGM, gsz = (nM - fm) < WGM ? (nM - fm) : WGM;
        u.pm = fm + ((wgid % nig) % gsz); u.pn = (wgid % nig) / gsz; return true;
    }
    __device__ __forceinline__ void a_ready(const Unit&) const {}
    __device__ __forceinline__ void done(const Unit&) const {}
};

__device__ __forceinline__ unsigned cvt_pk_bf16(float lo, float hi) { unsigned r; asm volatile("v_cvt_pk_bf16_f32 %0, %1, %2" : "=v"(r) : "v"(lo), "v"(hi)); return r; }
typedef float f32x2 __attribute__((ext_vector_type(2)));
template <class Epi, class Sched, bool ALIGN_EPI = false, bool SP2 = false>
__device__ __forceinline__ void gemm_phase(PG8_LAS unsigned char* lds, const Gemm g, const Sched& S, const Epi& E) {
    int tid_ = threadIdx.x; asm volatile("" : "+v"(tid_));
    const int tid = tid_, wid = __builtin_amdgcn_readfirstlane(tid >> 6), lane = tid & 63, wr = wid >> 2, wc = wid & 3, fr = lane & 15, fq = lane >> 4;
    const int K = g.K, nt = K / BK;
    unsigned voffA[2], voffB[2];
#pragma unroll
    for (int i = 0; i < 2; ++i) { int R, C; stage_rc(tid * 16 + i * 8192, R, C); const int Rb = Epi::PERM ? ((R & ~31) + perm32(R & 31)) : R;
        voffA[i] = (unsigned)(R * K + C) * 2u; voffB[i] = (unsigned)(Rb * K + C) * 2u; }
    const size_t kstep = (size_t)(BK * 2);
    const size_t hstep = (size_t)HALF * K * 2;
    const size_t tstep = 2 * hstep;
    const unsigned ldsw = (unsigned)wid * 1024u;
    const int aoff = lds_byte(wr * 64 + fr, fq * 8), boff = lds_byte(wc * 32 + fr, fq * 8);
#define PG8_SA(b, h) (((b) * 2 + (h)) * HTB)
#define PG8_SB(b, h) ((4 + (b) * 2 + (h)) * HTB)
#define PG8_STAGE(bufoff, gbase, voff) do { _Pragma("unroll") for (int _i = 0; _i < 2; ++_i) \
        __builtin_amdgcn_global_load_lds((const unsigned*)((const char*)(gbase) + (voff)[_i]), (PG8_LAS unsigned*)(lds + (bufoff) + ldsw + _i * 8192), 16, 0, 0); } while (0)
#define PG8_LDA(dst, b, h) do { _Pragma("unroll") for (int m = 0; m < 4; ++m) _Pragma("unroll") for (int k = 0; k < 2; ++k) dst[m][k] = *(const PG8_LAS bf16x8*)(lds + PG8_SA(b, h) + aoff + m * 2048 + k * 1024); } while (0)
#define PG8_LDB(dst, b, h) do { _Pragma("unroll") for (int n = 0; n < 2; ++n) _Pragma("unroll") for (int k = 0; k < 2; ++k) dst[n][k] = *(const PG8_LAS bf16x8*)(lds + PG8_SB(b, h) + boff + n * 2048 + k * 1024); } while (0)
#define PG8_MMA(ai, bj, At, Bt) do { __builtin_amdgcn_s_setprio(1); _Pragma("unroll") for (int m = 0; m < 4; ++m) _Pragma("unroll") for (int n = 0; n < 2; ++n) _Pragma("unroll") for (int k = 0; k < 2; ++k) \
        acc[ai][bj][m][n] = __builtin_amdgcn_mfma_f32_16x16x32_bf16(Bt[n][k], At[m][k], acc[ai][bj][m][n], 0, 0, 0); __builtin_amdgcn_s_setprio(0); } while (0)
#define PG8_WAIT_V(n) asm volatile("s_waitcnt vmcnt(" #n ")" ::: "memory")
#define PG8_WAIT_L(n) asm volatile("s_waitcnt lgkmcnt(" #n ")" ::: "memory")
#define PG8_BAR __builtin_amdgcn_s_barrier()
#define PG8_SCHED __builtin_amdgcn_sched_barrier(0)
    Unit cur, nxt; int ui = 0;
    if (!S.next(0, cur)) return;
    f32x4 acc[2][2][4][2];
#pragma unroll
    for (int a = 0; a < 2; ++a)
#pragma unroll
        for (int b = 0; b < 2; ++b)
#pragma unroll
            for (int m = 0; m < 4; ++m)
#pragma unroll
                for (int n = 0; n < 2; ++n) acc[a][b][m][n] = (f32x4){0.f, 0.f, 0.f, 0.f};
    bf16x8 At[4][2], B0[2][2], B1[2][2];
    const char* cA = (const char*)g.A + (size_t)cur.pm * tstep; const char* cB = (const char*)g.Bt + (size_t)cur.pn * tstep;
    S.a_ready(cur);
    if constexpr (SP2) {
        PG8_STAGE(PG8_SB(0, 0), cB, voffB); PG8_STAGE(PG8_SB(0, 1), cB + hstep, voffB); PG8_STAGE(PG8_SA(0, 0), cA, voffA); PG8_STAGE(PG8_SA(0, 1), cA + hstep, voffA);
        if (wr == 1) PG8_BAR;
        PG8_WAIT_V(2); PG8_BAR;
        PG8_STAGE(PG8_SB(1, 0), cB + kstep, voffB); PG8_STAGE(PG8_SA(1, 0), cA + kstep, voffA); PG8_STAGE(PG8_SB(1, 1), cB + hstep + kstep, voffB);
        PG8_WAIT_V(6); PG8_BAR;
    } else {
        PG8_STAGE(PG8_SB(0, 0), cB, voffB); PG8_STAGE(PG8_SA(0, 0), cA, voffA); PG8_STAGE(PG8_SB(0, 1), cB + hstep, voffB); PG8_STAGE(PG8_SA(0, 1), cA + hstep, voffA);
        if (wr == 1) PG8_BAR;
        PG8_WAIT_V(4); PG8_BAR;
        PG8_STAGE(PG8_SB(1, 0), cB + kstep, voffB); PG8_STAGE(PG8_SA(1, 0), cA + kstep, voffA); PG8_STAGE(PG8_SB(1, 1), cB + hstep + kstep, voffB);
        PG8_WAIT_V(6); PG8_BAR;
    }
    for (;;) {
        const bool has_next = S.next(ui + 1, nxt);
        const char* nA = has_next ? (const char*)g.A + (size_t)nxt.pm * tstep : cA; const char* nB = has_next ? (const char*)g.Bt + (size_t)nxt.pn * tstep : cB;
        for (int t = 0; t < nt; t += 2) {
            const bool last = (t == nt - 2);
            const char* a1 = cA + (size_t)(t + 1) * kstep;
            const char* a2 = last ? nA : cA + (size_t)(t + 2) * kstep; const char* b2 = last ? nB : cB + (size_t)(t + 2) * kstep;
            const char* a3 = a2 + kstep; const char* b3 = b2 + kstep;
            if (last && has_next) S.a_ready(nxt);
            if constexpr (SP2) {
            PG8_LDB(B0, 0, 0); PG8_LDB(B1, 0, 1); PG8_SCHED; PG8_LDA(At, 0, 0); PG8_STAGE(PG8_SA(1, 1), a1 + hstep, voffA);
            PG8_WAIT_V(8); PG8_WAIT_L(0); PG8_BAR; PG8_MMA(0, 0, At, B0); PG8_MMA(0, 1, At, B1); PG8_BAR; PG8_SCHED;
            PG8_LDA(At, 0, 1); PG8_STAGE(PG8_SB(0, 0), b2, voffB); PG8_STAGE(PG8_SB(0, 1), b2 + hstep, voffB); PG8_STAGE(PG8_SA(0, 0), a2, voffA);
            PG8_WAIT_V(8); PG8_WAIT_L(0); PG8_BAR; PG8_MMA(1, 0, At, B0); PG8_MMA(1, 1, At, B1); PG8_BAR; PG8_SCHED;
            PG8_LDB(B0, 1, 0); PG8_LDB(B1, 1, 1); PG8_SCHED; PG8_LDA(At, 1, 0); PG8_STAGE(PG8_SA(0, 1), a2 + hstep, voffA);
            PG8_WAIT_V(8); PG8_WAIT_L(0); PG8_BAR; PG8_MMA(0, 0, At, B0); PG8_MMA(0, 1, At, B1); PG8_BAR; PG8_SCHED;
            PG8_LDA(At, 1, 1); PG8_STAGE(PG8_SB(1, 0), b3, voffB); PG8_STAGE(PG8_SB(1, 1), b3 + hstep, voffB); PG8_STAGE(PG8_SA(1, 0), a3, voffA);
            PG8_WAIT_V(8); PG8_WAIT_L(0); PG8_BAR; PG8_MMA(1, 0, At, B0); PG8_MMA(1, 1, At, B1); PG8_BAR; PG8_SCHED;
            } else {
            PG8_LDB(B0, 0, 0); PG8_SCHED; PG8_LDA(At, 0, 0); PG8_STAGE(PG8_SA(1, 1), a1 + hstep, voffA);
            PG8_WAIT_L(8); PG8_BAR; PG8_WAIT_L(0); PG8_MMA(0, 0, At, B0); PG8_BAR; PG8_SCHED;
            PG8_LDB(B1, 0, 1); PG8_STAGE(PG8_SB(0, 0), b2, voffB);
            PG8_BAR; PG8_WAIT_L(0); PG8_MMA(0, 1, At, B1); PG8_BAR;
            PG8_LDA(At, 0, 1); PG8_STAGE(PG8_SA(0, 0), a2, voffA);
            PG8_BAR; PG8_WAIT_L(0); PG8_MMA(1, 0, At, B0); PG8_BAR; PG8_SCHED;
            PG8_STAGE(PG8_SB(0, 1), b2 + hstep, voffB);
            PG8_WAIT_V(6); PG8_BAR; PG8_MMA(1, 1, At, B1); PG8_BAR;
            PG8_LDB(B0, 1, 0); PG8_SCHED; PG8_LDA(At, 1, 0); PG8_STAGE(PG8_SA(0, 1), a2 + hstep, voffA);
            PG8_WAIT_L(8); PG8_BAR; PG8_WAIT_L(0); PG8_MMA(0, 0, At, B0); PG8_BAR; PG8_SCHED;
            PG8_LDB(B1, 1, 1); PG8_STAGE(PG8_SB(1, 0), b3, voffB);
            PG8_BAR; PG8_WAIT_L(0); PG8_MMA(0, 1, At, B1); PG8_BAR;
            PG8_LDA(At, 1, 1); PG8_STAGE(PG8_SA(1, 0), a3, voffA);
            PG8_BAR; PG8_WAIT_L(0); PG8_MMA(1, 0, At, B0); PG8_BAR; PG8_SCHED;
            PG8_STAGE(PG8_SB(1, 1), b3 + hstep, voffB);
            PG8_WAIT_V(6); PG8_BAR; PG8_MMA(1, 1, At, B1); PG8_BAR;
            }
        }
        if constexpr (ALIGN_EPI) { if (wr == 0) PG8_BAR; }
        if constexpr (!Epi::AFTER_DRAIN) { E(acc, cur, wr, wc, fr, fq); S.done(cur); }
        if (!has_next) break;
#pragma unroll
        for (int a = 0; a < 2; ++a)
#pragma unroll
            for (int b = 0; b < 2; ++b)
#pragma unroll
                for (int m = 0; m < 4; ++m)
#pragma unroll
                    for (int n = 0; n < 2; ++n) acc[a][b][m][n] = (f32x4){0.f, 0.f, 0.f, 0.f};
        cur = nxt; cA = nA; cB = nB; ++ui;
        if constexpr (ALIGN_EPI) { if (wr == 1) PG8_BAR; }
    }
    PG8_WAIT_V(0);
    if constexpr (!ALIGN_EPI) { if (wr == 0) PG8_BAR; }
    PG8_BAR;
    if constexpr (Epi::AFTER_DRAIN) { E.fused(acc, cur, wr, wc, fr, fq, lds, wid, lane); S.done(cur); }
#undef PG8_SA
#undef PG8_SB
#undef PG8_STAGE
#undef PG8_LDA
#undef PG8_LDB
#undef PG8_MMA
#undef PG8_WAIT_V
#undef PG8_WAIT_L
#undef PG8_BAR
#undef PG8_SCHED
}
}

#define DI __device__ __forceinline__
#define LAS __attribute__((address_space(3)))
typedef unsigned short bf16_t;
typedef short bf16x8 __attribute__((ext_vector_type(8)));
typedef short s16x4 __attribute__((ext_vector_type(4)));
typedef float f32x4 __attribute__((ext_vector_type(4)));
typedef float f32x8 __attribute__((ext_vector_type(8)));
typedef float f32x16 __attribute__((ext_vector_type(16)));
typedef unsigned u32x4 __attribute__((ext_vector_type(4)));
typedef unsigned u32x2 __attribute__((ext_vector_type(2)));
typedef __bf16 bf8v __attribute__((ext_vector_type(8)));
typedef __bf16 bf4v __attribute__((ext_vector_type(4)));

constexpr int NB = 2, S = 8192, DM = 2048, MT = NB * S, NL = 4, HD = 64, NCOL = 8200, NPROJ = 8192;
constexpr float LOG2E = 1.4426950408889634f, LN2 = 0.6931471805599453f;
constexpr size_t MiB = 1u << 20;
constexpr size_t WS_CTL = 0, CTL_BYTES = 65536;
constexpr size_t WS_WIN = 1 * MiB;
constexpr size_t WS_WOUT = 129 * MiB;
constexpr size_t WS_XB = 161 * MiB;
constexpr size_t WS_Q = 225 * MiB;
constexpr size_t WS_K = 289 * MiB;
constexpr size_t WS_VT = 353 * MiB;
constexpr size_t WS_VTX = 417 * MiB;
constexpr size_t WS_G = 449 * MiB;
constexpr size_t WS_Y = 513 * MiB;
constexpr size_t WS_LOGF = 577 * MiB;
constexpr size_t WS_F = WS_LOGF + 512 * 1024;
constexpr size_t WS_KMP = 578 * MiB;
constexpr size_t WS_COS = 579 * MiB, WS_SIN = 580 * MiB;
constexpr size_t WS_WF = 581 * MiB;
constexpr size_t WS_END = 582 * MiB;
constexpr int LDS_BYTES = 147456;

struct Args { const float *x, *ng, *w_in, *qg, *kg, *fb, *w_out; float* out; unsigned char* ws; float inv_freq[32]; };

DI unsigned f2bf(float f) { unsigned u = __builtin_bit_cast(unsigned, f); return (u + 0x7fffu + ((u >> 16) & 1u)) >> 16; }
DI unsigned pk2(float lo, float hi) { return f2bf(lo) | (f2bf(hi) << 16); }
DI float bf2f(unsigned short b) { return __builtin_bit_cast(float, (unsigned)b << 16); }
DI bf16x8 pack8(f32x8 v) { bf8v b = __builtin_convertvector(v, bf8v); return __builtin_bit_cast(bf16x8, b); }
DI s16x4 pack4(f32x4 v) { bf4v b = __builtin_convertvector(v, bf4v); return __builtin_bit_cast(s16x4, b); }
template <int O> DI int shxi(int v) {
    if constexpr (O < 32) return __builtin_amdgcn_ds_swizzle(v, 0x1f | (O << 10));
    else { const auto r = __builtin_amdgcn_permlane32_swap((unsigned)v, (unsigned)v, false, false); return (int)((threadIdx.x & 32u) ? r[0] : r[1]); }
}
template <int O> DI float shx(float v) { return __builtin_bit_cast(float, shxi<O>(__builtin_bit_cast(int, v))); }
DI float wave_sum(float v) { v += shx<1>(v); v += shx<2>(v); v += shx<4>(v); v += shx<8>(v); v += shx<16>(v); v += shx<32>(v); return v; }
DI float wave_max(float v) { v = fmaxf(v, shx<1>(v)); v = fmaxf(v, shx<2>(v)); v = fmaxf(v, shx<4>(v)); v = fmaxf(v, shx<8>(v)); v = fmaxf(v, shx<16>(v)); v = fmaxf(v, shx<32>(v)); return v; }
DI f32x16 mfma32(bf16x8 a, bf16x8 b, f32x16 c) { return __builtin_amdgcn_mfma_f32_32x32x16_bf16(a, b, c, 0, 0, 0); }
DI float ex2(float x) { return __builtin_amdgcn_exp2f(x); }
DI float lg2(float x) { return __builtin_amdgcn_logf(x); }

struct EpiIn {
    static constexpr bool PERM = true, AFTER_DRAIN = false;
    bf16_t *Q, *K, *VT, *VTX, *G; float* KMP; const float *qg, *kg, *cosT, *sinT;
    __device__ __forceinline__ void operator()(const pg8::f32x4 (&acc)[2][2][4][2], const pg8::Unit& u, int wr, int wc, int fr, int fq) const {
        const int ms = (u.pn & 7) >> 1, mixer = ((ms & 1) << 1) | (ms >> 1);
        const int sec = u.pn >> 3, head = 4 * (u.pn & 1) + wc;
        const int b = u.pm >> 5, blk = u.pm & 31, sbase = blk * 256 + wr * 64 + fr, bh = b * 8 + head;
        if (sec <= 1) {
            const bool norm = mixer != 1, rope = (mixer == 0 || mixer == 2), km = (sec == 1 && mixer == 2);
            const float* gp = (sec == 0 ? qg : kg) + (mixer == 0 ? 0 : (mixer == 2 ? 1 : 2)) * 64;
            f32x4 gn[2][2], ks[2][2];
#pragma unroll
            for (int bj = 0; bj < 2; ++bj)
#pragma unroll
                for (int n = 0; n < 2; ++n) { gn[bj][n] = norm ? *(const f32x4*)(gp + 32 * bj + 8 * fq + 4 * n) : (f32x4){1.f, 1.f, 1.f, 1.f}; ks[bj][n] = (f32x4){0.f, 0.f, 0.f, 0.f}; }
            bf16_t* dst = (sec == 0 ? Q : K) + (size_t)(mixer * 16 + bh) * S * 64;
            const float osc = sec == 0 ? (mixer == 1 ? 0.125f : 0.125f * LOG2E) : 1.0f;
#pragma unroll
            for (int ai = 0; ai < 2; ++ai)
#pragma unroll
                for (int m = 0; m < 4; ++m) {
                    const int s = sbase + 128 * ai + 16 * m;
                    f32x4 v[2][2];
#pragma unroll
                    for (int bj = 0; bj < 2; ++bj)
#pragma unroll
                        for (int n = 0; n < 2; ++n) v[bj][n] = acc[ai][bj][m][n];
                    if (norm) {
                        float ss = 0.f;
#pragma unroll
                        for (int bj = 0; bj < 2; ++bj)
#pragma unroll
                            for (int n = 0; n < 2; ++n) { const f32x4 t = v[bj][n]; ss += (t[0] * t[0] + t[1] * t[1]) + (t[2] * t[2] + t[3] * t[3]); }
                        ss += shx<16>(ss); ss += shx<32>(ss);
                        const float rr = rsqrtf(ss * (1.0f / 64.0f) + 1e-6f);
#pragma unroll
                        for (int bj = 0; bj < 2; ++bj)
#pragma unroll
                            for (int n = 0; n < 2; ++n) v[bj][n] = v[bj][n] * rr * gn[bj][n];
                    }
                    if (rope) {
#pragma unroll
                        for (int n = 0; n < 2; ++n) {
                            const f32x4 c4 = *(const f32x4*)(cosT + (size_t)s * 32 + 8 * fq + 4 * n), s4 = *(const f32x4*)(sinT + (size_t)s * 32 + 8 * fq + 4 * n);
                            const f32x4 t1 = v[0][n], t2 = v[1][n];
                            v[0][n] = t1 * c4 - t2 * s4; v[1][n] = t2 * c4 + t1 * s4;
                        }
                    }
                    if (km) {
#pragma unroll
                        for (int bj = 0; bj < 2; ++bj)
#pragma unroll
                            for (int n = 0; n < 2; ++n) ks[bj][n] += v[bj][n];
                    }
#pragma unroll
                    for (int bj = 0; bj < 2; ++bj) {
                        const f32x4 a0 = v[bj][0] * osc, a1 = v[bj][1] * osc;
                        const bf16x8 w = pack8((f32x8){a0[0], a0[1], a0[2], a0[3], a1[0], a1[1], a1[2], a1[3]});
                        *(bf16x8*)(dst + (size_t)s * 64 + 32 * bj + 8 * fq) = w;
                    }
                }
            if (km) {
#pragma unroll
                for (int bj = 0; bj < 2; ++bj)
#pragma unroll
                    for (int n = 0; n < 2; ++n) {
                        f32x4 t = ks[bj][n];
#pragma unroll
                        for (int e = 0; e < 4; ++e) { float x = t[e]; x += shx<1>(x); x += shx<2>(x); x += shx<4>(x); x += shx<8>(x); t[e] = x; }
                        if (fr == 0) *(f32x4*)(KMP + ((size_t)(bh * 32 + blk) * 2 + wr) * 64 + 32 * bj + 8 * fq + 4 * n) = t;
                    }
            }
        } else if (sec == 2) {
            bf16_t* vt = VT + (size_t)(mixer * 16 + bh) * 64 * S;
            bf16_t* vx0 = VTX + (size_t)bh * 64 * S;
            bf16_t* vx1 = VTX + (size_t)(16 + bh) * 64 * S;
#pragma unroll
            for (int ai = 0; ai < 2; ++ai)
#pragma unroll
                for (int m = 0; m < 4; ++m) {
                    const int s = sbase + 128 * ai + 16 * m;
                    const int s4 = (s & 3) * (S / 4) + (s >> 2), s16 = (s & 15) * (S / 16) + (s >> 4);
#pragma unroll
                    for (int bj = 0; bj < 2; ++bj)
#pragma unroll
                        for (int n = 0; n < 2; ++n)
#pragma unroll
                            for (int e = 0; e < 4; ++e) {
                                const int d = 32 * bj + 8 * fq + 4 * n + e;
                                const bf16_t w = (bf16_t)f2bf(acc[ai][bj][m][n][e]);
                                vt[(size_t)d * S + s] = w;
                            }
                }
            if (mixer == 0) {
#pragma unroll
                for (int ai = 0; ai < 2; ++ai) {
                    const int s0 = sbase + 128 * ai, s16 = (s0 & 15) * (S / 16) + (s0 >> 4);
                    const int s4p = (fr & 3) * (S / 4) + ((s0 - fr) >> 2) + 4 * (fr >> 2);
#pragma unroll
                    for (int bj = 0; bj < 2; ++bj)
#pragma unroll
                        for (int n = 0; n < 2; ++n)
#pragma unroll
                            for (int e = 0; e < 4; ++e) {
                                const int d = 32 * bj + 8 * fq + 4 * n + e;
                                const f32x4 t = {acc[ai][bj][0][n][e], acc[ai][bj][1][n][e], acc[ai][bj][2][n][e], acc[ai][bj][3][n][e]};
                                const s16x4 w4 = pack4(t);
                                *(s16x4*)(vx1 + (size_t)d * S + s16) = w4;
                                *(s16x4*)(vx0 + (size_t)d * S + s4p) = w4;
                            }
                }
            }
        } else {
            const int col = 512 * mixer + 256 * (u.pn & 1) + 64 * wc + 8 * fq;
#pragma unroll
            for (int ai = 0; ai < 2; ++ai)
#pragma unroll
                for (int m = 0; m < 4; ++m) {
                    const size_t row = (size_t)u.pm * 256 + 128 * ai + 64 * wr + 16 * m + fr;
#pragma unroll
                    for (int bj = 0; bj < 2; ++bj) {
                        f32x8 t;
#pragma unroll
                        for (int n = 0; n < 2; ++n)
#pragma unroll
                            for (int e = 0; e < 4; ++e) { const float z = acc[ai][bj][m][n][e]; t[4 * n + e] = z / (1.0f + __expf(-z)); }
                        *(bf16x8*)(G + row * DM + col + 32 * bj) = pack8(t);
                    }
                }
        }
    }
};
struct EpiOut {
    static constexpr bool PERM = false, AFTER_DRAIN = false;
    const float* src; float* out;
    __device__ __forceinline__ void operator()(const pg8::f32x4 (&acc)[2][2][4][2], const pg8::Unit& u, int wr, int wc, int fr, int fq) const {
#pragma unroll
        for (int ai = 0; ai < 2; ++ai)
#pragma unroll
            for (int m = 0; m < 4; ++m) {
                const size_t row = (size_t)u.pm * 256 + 128 * ai + 64 * wr + 16 * m + fr;
#pragma unroll
                for (int bj = 0; bj < 2; ++bj)
#pragma unroll
                    for (int n = 0; n < 2; ++n) {
                        const size_t off = row * DM + u.pn * 256 + 128 * bj + 32 * wc + 16 * n + 4 * fq;
                        const f32x4 r = *(const f32x4*)(src + off);
                        *(f32x4*)(out + off) = r + acc[ai][bj][m][n];
                    }
                asm volatile("" ::: "memory");
            }
    }
};

DI void transpose_item(const float* W, int ldw, const float* gain, bf16_t* WT, int K, int k0, int n0, int nd, LAS float* scr, int lane) {
    f32x4 tw[8]; float gg[8];
#pragma unroll
    for (int i = 0; i < 8; ++i) { const int kk = 8 * i + (lane >> 3); tw[i] = *(const f32x4*)(W + (size_t)(k0 + kk) * ldw + n0 + 4 * (lane & 7)); gg[i] = gain ? gain[k0 + kk] : 1.0f; }
#pragma unroll
    for (int i = 0; i < 8; ++i) { const int kk = 8 * i + (lane >> 3); LAS float* d = scr + kk * 33 + 4 * (lane & 7);
        d[0] = tw[i][0] * gg[i]; d[1] = tw[i][1] * gg[i]; d[2] = tw[i][2] * gg[i]; d[3] = tw[i][3] * gg[i]; }
    asm volatile("s_waitcnt lgkmcnt(0)" ::: "memory");
    const int c = lane & 7;
#pragma unroll
    for (int j = 0; j < 4; ++j) { const int n = (lane >> 3) + 8 * j; const LAS float* s = scr + (8 * c) * 33 + n;
        u32x4 o; o.x = pk2(s[0 * 33], s[1 * 33]); o.y = pk2(s[2 * 33], s[3 * 33]); o.z = pk2(s[4 * 33], s[5 * 33]); o.w = pk2(s[6 * 33], s[7 * 33]);
        *(u32x4*)(WT + (size_t)(nd + n) * K + k0 + 8 * c) = o; }
    asm volatile("s_waitcnt lgkmcnt(0)" ::: "memory");
}

DI void norm_row(const float* xrow, const LAS f32x4* wfl, const float* fbias, bf16_t* orow, float* logf_b  , int s, int lane) {
    asm volatile("" ::: "memory");
    f32x4 v[8]; float ss = 0.f; float fl[8];
#pragma unroll
    for (int h = 0; h < 8; ++h) fl[h] = 0.f;
#pragma unroll
    for (int j = 0; j < 8; ++j) { v[j] = ((const f32x4*)xrow)[lane + 64 * j]; ss += (v[j][0] * v[j][0] + v[j][1] * v[j][1]) + (v[j][2] * v[j][2] + v[j][3] * v[j][3]); }
#pragma unroll
    for (int j = 0; j < 8; ++j) {
#pragma unroll
        for (int e = 0; e < 4; ++e) {
            const float xg = v[j][e];
            const f32x4 w0 = wfl[((j * 4 + e) * 2 + 0) * 64 + lane], w1 = wfl[((j * 4 + e) * 2 + 1) * 64 + lane];
            fl[0] += xg * w0[0]; fl[1] += xg * w0[1]; fl[2] += xg * w0[2]; fl[3] += xg * w0[3];
            fl[4] += xg * w1[0]; fl[5] += xg * w1[1]; fl[6] += xg * w1[2]; fl[7] += xg * w1[3];
        }
    }
    ss = wave_sum(ss);
#pragma unroll
    for (int h = 0; h < 8; ++h) fl[h] = wave_sum(fl[h]);
    const float rstd = rsqrtf(ss * (1.0f / DM) + 1e-6f);
    unsigned long long* o8 = (unsigned long long*)orow + lane;
#pragma unroll
    for (int j = 0; j < 8; ++j) o8[64 * j] = (unsigned long long)pk2(v[j][0] * rstd, v[j][1] * rstd) | ((unsigned long long)pk2(v[j][2] * rstd, v[j][3] * rstd) << 32);
    float mine = fl[0];
#pragma unroll
    for (int h = 1; h < 8; ++h) mine = (lane == h) ? fl[h] : mine;
    if (lane < 8) {
        const float z = mine * rstd + fbias[lane];
        const float lf = fminf(z, 0.f) - log1pf(expf(-fabsf(z)));
        logf_b[(size_t)lane * S + s] = lf;
    }
}

DI int crow(int i, int h) { return (i & 3) + 8 * (i >> 2) + 4 * h; }
DI int kperm(int r) { return (r & ~12) | ((r & 4) << 1) | ((r & 8) >> 1); }
DI int kidx(int i, int h) { return 16 * (i >> 3) + 8 * h + (i & 7); }
DI int uperm(int x, bool on) { return on ? ((x & ~15) | ((x & 3) << 2) | ((x >> 2) & 3)) : x; }
DI void load_q(bf16x8 (&qf)[4], const bf16_t* qrow) {
#pragma unroll
    for (int sp = 0; sp < 4; ++sp) qf[sp] = *(const bf16x8*)(qrow + 16 * sp);
}
DI void load_v(bf16x8 (&vf)[2][2], const bf16_t* vb  ) {
#pragma unroll
    for (int dd = 0; dd < 2; ++dd)
#pragma unroll
        for (int s = 0; s < 2; ++s) vf[dd][s] = *(const bf16x8*)(vb + (size_t)dd * 32 * S + 16 * s);
}
DI f32x16 qk_tile(const bf16x8 (&kf)[4], const bf16x8 (&qf)[4]) {
    f32x16 x;
#pragma unroll
    for (int i = 0; i < 16; ++i) x[i] = 0.f;
#pragma unroll
    for (int sp = 0; sp < 4; ++sp) x = mfma32(kf[sp], qf[sp], x);
    return x;
}
DI void pv_tile(f32x16& o0, f32x16& o1, const bf16x8 (&vf)[2][2], const float (&p)[16]) {
    const bf16x8 p0 = pack8((f32x8){p[0], p[1], p[2], p[3], p[4], p[5], p[6], p[7]});
    const bf16x8 p1 = pack8((f32x8){p[8], p[9], p[10], p[11], p[12], p[13], p[14], p[15]});
    o0 = mfma32(vf[0][0], p0, o0); o0 = mfma32(vf[0][1], p1, o0);
    o1 = mfma32(vf[1][0], p0, o1); o1 = mfma32(vf[1][1], p1, o1);
}
DI void store_y(const f32x16& o0, const f32x16& o1, float inv, const bf16_t* G, bf16_t* Y, size_t row, int col0, int h) {
#pragma unroll
    for (int dd = 0; dd < 2; ++dd)
#pragma unroll
        for (int gp = 0; gp < 2; ++gp) {
            const int g = 2 * gp;
            const size_t off = row * DM + col0 + 32 * dd + 8 * (g + h);
            const u32x4 gq = *(const u32x4*)(G + off);
            const auto s0 = __builtin_amdgcn_permlane32_swap(gq.x, gq.z, false, false);
            const auto s1 = __builtin_amdgcn_permlane32_swap(gq.y, gq.w, false, false);
            const unsigned gg[2] = {s0[0], s1[0]}, gh[2] = {s0[1], s1[1]};
            f32x4 tg, th;
#pragma unroll
            for (int e = 0; e < 4; ++e) {
                const float og = (dd == 0 ? o0[4 * g + e] : o1[4 * g + e]), oh = (dd == 0 ? o0[4 * g + 4 + e] : o1[4 * g + 4 + e]);
                const unsigned wg = gg[e >> 1], wh = gh[e >> 1];
                tg[e] = og * inv * bf2f((unsigned short)((e & 1) ? (wg >> 16) : (wg & 0xffffu)));
                th[e] = oh * inv * bf2f((unsigned short)((e & 1) ? (wh >> 16) : (wh & 0xffffu)));
            }
            const u32x2 yg = __builtin_bit_cast(u32x2, pack4(tg)), yh = __builtin_bit_cast(u32x2, pack4(th));
            const auto t0 = __builtin_amdgcn_permlane32_swap(yg.x, yh.x, false, false);
            const auto t1 = __builtin_amdgcn_permlane32_swap(yg.y, yh.y, false, false);
            *(u32x4*)(Y + off) = (u32x4){t0[0], t1[0], t0[1], t1[1]};
        }
}

template <int MODE>
DI void attn_item(const bf16_t* Qm, const bf16_t* Km, const bf16_t* Vtm, const float* Fb, const float* KMPb, const bf16_t* G, bf16_t* Y, int bh, int qt, int mixer, float Mb, int lane) {
    asm volatile("" : "+v"(lane));
    const int r = lane & 31, h = lane >> 5;
    const int q0 = qt * 32, t = q0 + r;
    bf16x8 qf[4];
    load_q(qf, Qm + ((size_t)bh * S + t) * 64 + 8 * h);
    const bf16_t* kb = Km + ((size_t)bh * S + kperm(r)) * 64 + 8 * h;
    const bf16_t* vb = Vtm + ((size_t)bh * 64 + r) * S + 8 * h;
    const int qblk = qt >> 3;
    unsigned sel = 0u, vis = 0xffffffffu;
    float ft = 0.f, Ft0 = 0.f;
    if (MODE == 3) { ft = Fb[t]; Ft0 = Fb[q0]; }
    if (MODE == 2) {
        if (qblk > 0) {
            f32x16 gx;
#pragma unroll
            for (int i = 0; i < 16; ++i) gx[i] = 0.f;
#pragma unroll
            for (int sp = 0; sp < 4; ++sp) {
                const float* kp = KMPb + (size_t)(r * 2) * 64 + 16 * sp + 8 * h;
                const f32x4 a0 = *(const f32x4*)kp, a1 = *(const f32x4*)(kp + 4), b0 = *(const f32x4*)(kp + 64), b1 = *(const f32x4*)(kp + 68);
                f32x8 km, hi_f;
#pragma unroll
                for (int e = 0; e < 4; ++e) { km[e] = (a0[e] + b0[e]) * (1.0f / 256.0f); km[4 + e] = (a1[e] + b1[e]) * (1.0f / 256.0f); }
                const bf16x8 hi = pack8(km);
#pragma unroll
                for (int e = 0; e < 8; ++e) hi_f[e] = km[e] - bf2f((unsigned short)hi[e]);
                const bf16x8 lo = pack8(hi_f);
                gx = mfma32(hi, qf[sp], gx); gx = mfma32(lo, qf[sp], gx);
            }
            const float NEGI = -__builtin_inff();
#pragma unroll
            for (int i = 0; i < 16; ++i) if (crow(i, h) >= qblk) gx[i] = NEGI;
#pragma unroll
            for (int it = 0; it < 3; ++it) {
                float bv = NEGI; int bn = 64;
#pragma unroll
                for (int i = 0; i < 16; ++i) if (gx[i] > bv) { bv = gx[i]; bn = crow(i, h); }
                const float pv = shx<32>(bv); const int pn = shxi<32>(bn);
                if (pv > bv || (pv == bv && pn < bn)) { bv = pv; bn = pn; }
                if (bv > NEGI) sel |= 1u << bn;
#pragma unroll
                for (int i = 0; i < 16; ++i) if (crow(i, h) == bn) gx[i] = NEGI;
            }
        }
        vis = sel;
        vis |= (unsigned)shxi<1>((int)vis); vis |= (unsigned)shxi<2>((int)vis); vis |= (unsigned)shxi<4>((int)vis); vis |= (unsigned)shxi<8>((int)vis); vis |= (unsigned)shxi<16>((int)vis); vis |= (unsigned)shxi<32>((int)vis);
        vis |= 1u << qblk;
    }
    f32x16 o0, o1;
#pragma unroll
    for (int i = 0; i < 16; ++i) { o0[i] = 0.f; o1[i] = 0.f; }
    float l = 0.f, R = 0.f;
    const float mb2 = -Mb * LOG2E;

    int tau = qt;
    bf16x8 kfA[4], vfA[2][2]; f32x4 fsA[4];
    load_q(kfA, kb + (size_t)tau * 32 * 64);
    load_v(vfA, vb + tau * 32);
    if (MODE == 3) {
#pragma unroll
        for (int g = 0; g < 4; ++g) fsA[g] = *(const f32x4*)(Fb + tau * 32 + 16 * (g >> 1) + 8 * h + 4 * (g & 1));
    }
    while (tau >= 0) {
        int nxt = tau - 1;
        if (MODE == 2) { while (nxt >= 0 && !((vis >> (nxt >> 3)) & 1u)) nxt = (nxt >> 3) * 8 - 1; }
        if (MODE == 3) { if (nxt >= 0) { const float fk = Fb[nxt * 32 + 31]; if ((Ft0 - fk) + 2.0f * Mb < -104.0f) nxt = -1; } }
        nxt = __builtin_amdgcn_readfirstlane(nxt);
        bf16x8 kfB[4], vfB[2][2]; f32x4 fsB[4];
#pragma unroll
        for (int sp = 0; sp < 4; ++sp) kfB[sp] = kfA[sp];
#pragma unroll
        for (int dd = 0; dd < 2; ++dd) { vfB[dd][0] = vfA[dd][0]; vfB[dd][1] = vfA[dd][1]; }
#pragma unroll
        for (int g = 0; g < 4; ++g) fsB[g] = fsA[g];
        if (nxt >= 0) {
            load_q(kfB, kb + (size_t)nxt * 32 * 64);
            load_v(vfB, vb + nxt * 32);
            if (MODE == 3) {
#pragma unroll
                for (int g = 0; g < 4; ++g) fsB[g] = *(const f32x4*)(Fb + nxt * 32 + 16 * (g >> 1) + 8 * h + 4 * (g & 1));
            }
        }
        const f32x16 x = qk_tile(kfA, qf);
        const bool diag = (tau == qt);
        float p[16];
        if (MODE == 1) {
            float sp_[16];
#pragma unroll
            for (int i = 0; i < 16; ++i) {
                const float z = x[i];
                sp_[i] = fmaxf(z, 0.f) + LN2 * lg2(1.0f + ex2(-fabsf(z) * LOG2E));
            }
            if (diag) {
#pragma unroll
                for (int i = 0; i < 16; ++i) if (!(kidx(i, h) < r)) sp_[i] = 0.f;
            }
            float sfx[16], T[2], bT[2];
#pragma unroll
            for (int o = 0; o < 2; ++o) {
                sfx[8 * o + 7] = sp_[8 * o + 7];
#pragma unroll
                for (int e = 6; e >= 0; --e) sfx[8 * o + e] = sp_[8 * o + e] + sfx[8 * o + e + 1];
                T[o] = sfx[8 * o];
                bT[o] = shx<32>(T[o]);
            }
            float off[2];
            off[1] = R + (h == 0 ? bT[1] : 0.f);
            off[0] = R + (T[1] + bT[1]) + (h == 0 ? bT[0] : 0.f);
            R = R + (T[1] + bT[1]) + (T[0] + bT[0]);
#pragma unroll
            for (int i = 0; i < 16; ++i) {
                const float c = off[i >> 3] + sfx[i];
                p[i] = ex2((x[i] - c) * LOG2E);
            }
            if (diag) {
#pragma unroll
                for (int i = 0; i < 16; ++i) if (!(kidx(i, h) < r)) p[i] = 0.f;
            }
        } else if (MODE == 2) {
            const int nb = tau >> 3;
            const bool own = (nb == qblk);
            const bool lane_ok = own || ((sel >> nb) & 1u);
#pragma unroll
            for (int i = 0; i < 16; ++i) {
                float v = ex2(fmaf(x[i], LOG2E, mb2));
                if (!lane_ok || (diag && kidx(i, h) > r)) v = 0.f;
                p[i] = v; l += v;
            }
        } else {
#pragma unroll
            for (int i = 0; i < 16; ++i) {
                const float dF = ft - fsA[i >> 2][i & 3];
                float v = ex2(fmaf(x[i], LOG2E, (dF - Mb) * LOG2E));
                if (diag && kidx(i, h) > r) v = 0.f;
                p[i] = v; l += v;
            }
        }
        pv_tile(o0, o1, vfA, p);
        if (MODE == 1) { if (__ballot(R < 104.0f) == 0ull) nxt = -1; }
#pragma unroll
        for (int sp = 0; sp < 4; ++sp) kfA[sp] = kfB[sp];
#pragma unroll
        for (int dd = 0; dd < 2; ++dd) { vfA[dd][0] = vfB[dd][0]; vfA[dd][1] = vfB[dd][1]; }
#pragma unroll
        for (int g = 0; g < 4; ++g) fsA[g] = fsB[g];
        tau = nxt;
    }
    float inv = 1.0f;
    if (MODE != 1) { l += shx<32>(l); inv = 1.0f / l; }
    store_y(o0, o1, inv, G, Y, (size_t)(bh >> 3) * S + t, mixer * 512 + (bh & 7) * 64, h);
}

constexpr int AW_K = 0, AW_V = 9216, AW_F = 9216 + 9216, AW_BUF = 9216 + 9216 + 256;
DI unsigned moba_select(const float* KMPb, const bf16x8 (&qf)[4], int qblk, int r, int h) {
    unsigned sel = 0u;
    if (qblk > 0) {
        f32x16 gx;
#pragma unroll
        for (int i = 0; i < 16; ++i) gx[i] = 0.f;
#pragma unroll
        for (int sp = 0; sp < 4; ++sp) {
            const float* kp = KMPb + (size_t)(r * 2) * 64 + 16 * sp + 8 * h;
            const f32x4 a0 = *(const f32x4*)kp, a1 = *(const f32x4*)(kp + 4), b0 = *(const f32x4*)(kp + 64), b1 = *(const f32x4*)(kp + 68);
            f32x8 km, hi_f;
#pragma unroll
            for (int e = 0; e < 4; ++e) { km[e] = (a0[e] + b0[e]) * (1.0f / 256.0f); km[4 + e] = (a1[e] + b1[e]) * (1.0f / 256.0f); }
            const bf16x8 hi = pack8(km);
#pragma unroll
            for (int e = 0; e < 8; ++e) hi_f[e] = km[e] - bf2f((unsigned short)hi[e]);
            const bf16x8 lo = pack8(hi_f);
            gx = mfma32(hi, qf[sp], gx); gx = mfma32(lo, qf[sp], gx);
        }
        const float NEGI = -__builtin_inff();
#pragma unroll
        for (int i = 0; i < 16; ++i) if (crow(i, h) >= qblk) gx[i] = NEGI;
#pragma unroll
        for (int it = 0; it < 3; ++it) {
            float bv = NEGI; int bn = 64;
#pragma unroll
            for (int i = 0; i < 16; ++i) if (gx[i] > bv) { bv = gx[i]; bn = crow(i, h); }
            const float pv = shx<32>(bv); const int pn = shxi<32>(bn);
            if (pv > bv || (pv == bv && pn < bn)) { bv = pv; bn = pn; }
            if (bv > NEGI) sel |= 1u << bn;
#pragma unroll
            for (int i = 0; i < 16; ++i) if (crow(i, h) == bn) gx[i] = NEGI;
        }
    }
    return sel;
}
DI unsigned wave_or(unsigned v) { v |= (unsigned)shxi<1>((int)v); v |= (unsigned)shxi<2>((int)v); v |= (unsigned)shxi<4>((int)v); v |= (unsigned)shxi<8>((int)v); v |= (unsigned)shxi<16>((int)v); v |= (unsigned)shxi<32>((int)v); return v; }

template <int MODE>
DI void sub_tile(const bf16x8 (&kf)[4], const bf16x8 (&vf)[2][2], const bf16x8 (&qf)[4], f32x16& o0, f32x16& o1, float& l, bool diag, float offs, float fm, const LAS float* fsp, int r, int h) {
    f32x16 x;
    float p[16];
    if (MODE == 2) {
#pragma unroll
        for (int i = 0; i < 16; ++i) x[i] = offs;
#pragma unroll
        for (int sp = 0; sp < 4; ++sp) x = mfma32(kf[sp], qf[sp], x);
#pragma unroll
        for (int i = 0; i < 16; ++i) p[i] = ex2(x[i]);
    } else {
        x = qk_tile(kf, qf);
#pragma unroll
        for (int g = 0; g < 4; ++g) {
            const f32x4 fs = *(const LAS f32x4*)(fsp + 16 * (g >> 1) + 8 * h + 4 * (g & 1));
#pragma unroll
            for (int e = 0; e < 4; ++e) p[4 * g + e] = ex2(x[4 * g + e] + (fm - fs[e]));
        }
    }
    if (diag) {
#pragma unroll
        for (int i = 0; i < 16; ++i) if (kidx(i, h) > r) p[i] = 0.f;
    }
#pragma unroll
    for (int i = 0; i < 16; ++i) l += p[i];
    pv_tile(o0, o1, vf, p);
}

template <int MODE>
DI void attn_wg2_item(const bf16_t* Qm, const bf16_t* Km, const bf16_t* Vtm, const float* Fb, const float* KMPb, const bf16_t* G, bf16_t* Y, int bh, int qb2, int halfq, int mixer, float Mb, LAS unsigned char* lds, int tid, int wave, int lane) {
    asm volatile("" : "+v"(tid), "+v"(lane));
    const int r = lane & 31, h = lane >> 5;
    const int qtA = halfq ? qb2 * 8 + wave : qb2 * 16 + wave, qtB = halfq ? -1 : qb2 * 16 + 15 - wave, tA = qtA * 32 + r, tB = halfq ? tA : qtB * 32 + r;
    bf16x8 qfA[4], qfB[4];
    load_q(qfA, Qm + ((size_t)bh * S + tA) * 64 + 8 * h);
    load_q(qfB, Qm + ((size_t)bh * S + tB) * 64 + 8 * h);
    const int qblkA = qtA >> 3, qblkB = halfq ? 0 : (qtB >> 3);
    unsigned selA = 0u, selB = 0u, visA = 0xffffffffu, visB = 0xffffffffu;
    float fmA = 0.f, fmB = 0.f, Ft0 = 0.f;
    if (MODE == 3) { fmA = (Fb[tA] - Mb) * LOG2E; fmB = (Fb[tB] - Mb) * LOG2E; Ft0 = Fb[halfq ? qb2 * 256 : qb2 * 512]; }
    if (MODE == 2) {
        selA = moba_select(KMPb, qfA, qblkA, r, h); selB = halfq ? 0u : moba_select(KMPb, qfB, qblkB, r, h);
        visA = wave_or(selA) | (1u << qblkA); visB = wave_or(selB) | (1u << qblkB);
    }
    f32x16 oA0, oA1, oB0, oB1;
#pragma unroll
    for (int i = 0; i < 16; ++i) { oA0[i] = 0.f; oA1[i] = 0.f; oB0[i] = 0.f; oB1[i] = 0.f; }
    float lA = 0.f, lB = 0.f;
    const float mb2 = -Mb * LOG2E, NEGI = -__builtin_inff();
    const int srow = tid >> 3, sch = tid & 7;
    const bf16_t* kg = Km + ((size_t)bh * S + srow) * 64 + sch * 8;
    const bf16_t* vg = Vtm + ((size_t)bh * 64 + srow) * S + sch * 8;
    const unsigned kws = AW_K + srow * 144 + sch * 16, vws = AW_V + srow * 144 + sch * 16;
    const unsigned kra = AW_K + kperm(r) * 144 + 16 * h, vra = AW_V + r * 144 + 16 * h;
    int cur = halfq ? qb2 * 4 + 3 : qb2 * 8 + 7, buf = 0;
    {
        const bf16x8 kreg = *(const bf16x8*)(kg + (size_t)cur * 4096);
        const u32x4 vreg = *(const u32x4*)(vg + cur * 64);
        *(LAS bf16x8*)(lds + kws) = kreg;
        *(LAS u32x4*)(lds + vws) = vreg;
        if (MODE == 3 && tid < 16) *(LAS f32x4*)(lds + AW_F + tid * 16) = *(const f32x4*)(Fb + cur * 64 + tid * 4) * LOG2E;
    }
    __syncthreads();
    while (cur >= 0) {
        int nxt = cur - 1;
        if (MODE == 3) { if (nxt >= 0) { const float fk = Fb[nxt * 64 + 63]; if ((Ft0 - fk) + 2.0f * Mb < -104.0f) nxt = -1; } }
        nxt = __builtin_amdgcn_readfirstlane(nxt);
        bf16x8 kreg; u32x4 vreg; f32x4 freg;
#pragma unroll
        for (int e = 0; e < 8; ++e) kreg[e] = 0;
        vreg = (u32x4){0u, 0u, 0u, 0u}; freg = (f32x4){0.f, 0.f, 0.f, 0.f};
        if (nxt >= 0) {
            kreg = *(const bf16x8*)(kg + (size_t)nxt * 4096);
            vreg = *(const u32x4*)(vg + nxt * 64);
            if (MODE == 3 && tid < 16) freg = *(const f32x4*)(Fb + nxt * 64 + tid * 4);
        }
        LAS unsigned char* lb = lds + buf * AW_BUF;
#pragma unroll
        for (int kk = 1; kk >= 0; --kk) {
            const int tau = cur * 2 + kk, nb = tau >> 3;
            bool actA = tau <= qtA, actB = tau <= qtB;
            if (MODE == 2) { actA = actA && ((visA >> nb) & 1u); actB = actB && ((visB >> nb) & 1u); }
            if (actA || actB) {
                bf16x8 kf[4], vf[2][2];
#pragma unroll
                for (int sp = 0; sp < 4; ++sp) kf[sp] = *(LAS bf16x8*)(lb + kra + kk * 32 * 144 + sp * 32);
#pragma unroll
                for (int dd = 0; dd < 2; ++dd)
#pragma unroll
                    for (int s = 0; s < 2; ++s) vf[dd][s] = *(LAS bf16x8*)(lb + vra + dd * 32 * 144 + kk * 64 + s * 32);
                float offA = mb2, offB = mb2;
                if (MODE == 2) { offA = ((nb == qblkA) || ((selA >> nb) & 1u)) ? mb2 : NEGI; offB = ((nb == qblkB) || ((selB >> nb) & 1u)) ? mb2 : NEGI; }
                const LAS float* fsp = (const LAS float*)(lb + AW_F) + kk * 32;
                if (actA) sub_tile<MODE>(kf, vf, qfA, oA0, oA1, lA, tau == qtA, offA, fmA, fsp, r, h);
                if (actB) sub_tile<MODE>(kf, vf, qfB, oB0, oB1, lB, tau == qtB, offB, fmB, fsp, r, h);
            }
        }
        if (nxt >= 0) {
            LAS unsigned char* nb_ = lds + (buf ^ 1) * AW_BUF;
            *(LAS bf16x8*)(nb_ + kws) = kreg;
            *(LAS u32x4*)(nb_ + vws) = vreg;
            if (MODE == 3 && tid < 16) *(LAS f32x4*)(nb_ + AW_F + tid * 16) = freg * LOG2E;
        }
        __syncthreads();
        buf ^= 1; cur = nxt;
    }
    lA += shx<32>(lA); lB += shx<32>(lB);
    store_y(oA0, oA1, 1.0f / lA, G, Y, (size_t)(bh >> 3) * S + tA, mixer * 512 + (bh & 7) * 64, h);
    if (!halfq) store_y(oB0, oB1, 1.0f / lB, G, Y, (size_t)(bh >> 3) * S + tB, mixer * 512 + (bh & 7) * 64, h);
}

DI void sub_tile_sb(const bf16x8 (&kf)[4], const bf16x8 (&vf)[2][2], const bf16x8 (&qf)[4], f32x16& o0, f32x16& o1, float& R, bool diag, int r, int h) {
    const f32x16 x = qk_tile(kf, qf);
    float sp_[16], p[16];
#pragma unroll
    for (int e = 0; e < 16; ++e) { const float z = x[e]; sp_[e] = fmaxf(z, 0.f) + LN2 * lg2(1.0f + ex2(-fabsf(z) * LOG2E)); }
    if (diag) {
#pragma unroll
        for (int e = 0; e < 16; ++e) if (!(kidx(e, h) < r)) sp_[e] = 0.f;
    }
    float sfx[16], T[2], bT[2];
#pragma unroll
    for (int o = 0; o < 2; ++o) {
        sfx[8 * o + 7] = sp_[8 * o + 7];
#pragma unroll
        for (int e = 6; e >= 0; --e) sfx[8 * o + e] = sp_[8 * o + e] + sfx[8 * o + e + 1];
        T[o] = sfx[8 * o];
        bT[o] = shx<32>(T[o]);
    }
    float off[2];
    off[1] = R + (h == 0 ? bT[1] : 0.f);
    off[0] = R + (T[1] + bT[1]) + (h == 0 ? bT[0] : 0.f);
    R = R + (T[1] + bT[1]) + (T[0] + bT[0]);
#pragma unroll
    for (int e = 0; e < 16; ++e) p[e] = ex2((x[e] - (off[e >> 3] + sfx[e])) * LOG2E);
    if (diag) {
#pragma unroll
        for (int e = 0; e < 16; ++e) if (!(kidx(e, h) < r)) p[e] = 0.f;
    }
    pv_tile(o0, o1, vf, p);
}
DI void attn_wgB_item(const bf16_t* Qm, const bf16_t* Km, const bf16_t* Vtm, const bf16_t* G, bf16_t* Y, int bh, int qb2, int halfq, LAS unsigned char* lds, int tid, int wave, int lane) {
    asm volatile("" : "+v"(tid), "+v"(lane));
    const int r = lane & 31, h = lane >> 5;
    const int qtA = halfq ? qb2 * 8 + wave : qb2 * 16 + wave, qtB = halfq ? -1 : qb2 * 16 + 15 - wave, tA = qtA * 32 + r, tB = halfq ? tA : qtB * 32 + r;
    bf16x8 qfA[4], qfB[4];
    load_q(qfA, Qm + ((size_t)bh * S + tA) * 64 + 8 * h);
    load_q(qfB, Qm + ((size_t)bh * S + tB) * 64 + 8 * h);
    f32x16 oA0, oA1, oB0, oB1;
#pragma unroll
    for (int i = 0; i < 16; ++i) { oA0[i] = 0.f; oA1[i] = 0.f; oB0[i] = 0.f; oB1[i] = 0.f; }
    float RA = 0.f, RB = 0.f;
    bool doneA = false, doneB = (halfq != 0);
    const int srow = tid >> 3, sch = tid & 7;
    const bf16_t* kg = Km + ((size_t)bh * S + srow) * 64 + sch * 8;
    const bf16_t* vg = Vtm + ((size_t)bh * 64 + srow) * S + sch * 8;
    const unsigned kws = AW_K + srow * 144 + sch * 16, vws = AW_V + srow * 144 + sch * 16;
    const unsigned kra = AW_K + kperm(r) * 144 + 16 * h, vra = AW_V + r * 144 + 16 * h;
    LAS int* fl = (LAS int*)(lds + 2 * AW_BUF);
    int cur = halfq ? qb2 * 4 + 3 : qb2 * 8 + 7, buf = 0, it = 0;
    {
        const bf16x8 kreg = *(const bf16x8*)(kg + (size_t)cur * 4096);
        const u32x4 vreg = *(const u32x4*)(vg + cur * 64);
        *(LAS bf16x8*)(lds + kws) = kreg;
        *(LAS u32x4*)(lds + vws) = vreg;
    }
    __syncthreads();
    while (cur >= 0) {
        int nxt = cur - 1;
        bf16x8 kreg; u32x4 vreg;
#pragma unroll
        for (int e = 0; e < 8; ++e) kreg[e] = 0;
        vreg = (u32x4){0u, 0u, 0u, 0u};
        if (nxt >= 0) {
            kreg = *(const bf16x8*)(kg + (size_t)nxt * 4096);
            vreg = *(const u32x4*)(vg + nxt * 64);
        }
        LAS unsigned char* lb = lds + buf * AW_BUF;
#pragma unroll
        for (int kk = 1; kk >= 0; --kk) {
            const int tau = cur * 2 + kk;
            const bool actA = (tau <= qtA) && !doneA, actB = (tau <= qtB) && !doneB;
            if (actA || actB) {
                bf16x8 kf[4], vf[2][2];
#pragma unroll
                for (int sp = 0; sp < 4; ++sp) kf[sp] = *(LAS bf16x8*)(lb + kra + kk * 32 * 144 + sp * 32);
#pragma unroll
                for (int dd = 0; dd < 2; ++dd)
#pragma unroll
                    for (int s = 0; s < 2; ++s) vf[dd][s] = *(LAS bf16x8*)(lb + vra + dd * 32 * 144 + kk * 64 + s * 32);
                if (actA) { sub_tile_sb(kf, vf, qfA, oA0, oA1, RA, tau == qtA, r, h); if (__ballot(RA < 104.0f) == 0ull) doneA = true; }
                if (actB) { sub_tile_sb(kf, vf, qfB, oB0, oB1, RB, tau == qtB, r, h); if (__ballot(RB < 104.0f) == 0ull) doneB = true; }
            }
        }
        if (nxt >= 0) {
            LAS unsigned char* nb_ = lds + (buf ^ 1) * AW_BUF;
            *(LAS bf16x8*)(nb_ + kws) = kreg;
            *(LAS u32x4*)(nb_ + vws) = vreg;
        }
        if (lane == 0) fl[(it & 1) * 8 + wave] = (doneA && doneB) ? 1 : 0;
        __syncthreads();
        int all = 1;
#pragma unroll
        for (int w = 0; w < 8; ++w) all &= fl[(it & 1) * 8 + w];
        if (__builtin_amdgcn_readfirstlane(all)) nxt = -1;
        buf ^= 1; cur = nxt; ++it;
    }
    store_y(oA0, oA1, 1.0f, G, Y, (size_t)(bh >> 3) * S + tA, 1 * 512 + (bh & 7) * 64, h);
    if (!halfq) store_y(oB0, oB1, 1.0f, G, Y, (size_t)(bh >> 3) * S + tB, 1 * 512 + (bh & 7) * 64, h);
}

DI void attn_A_item(const bf16_t* Q0, const bf16_t* K0, const bf16_t* VT0, const bf16_t* VTXp, const bf16_t* G, bf16_t* Y, int bh, int blk, float Mb, LAS float* Oacc, LAS float* lacc, int tid, int wave, int lane) {
    asm volatile("" : "+v"(tid), "+v"(lane));
    const int r = lane & 31, h = lane >> 5, t0 = blk * 512;
    {
        LAS f32x4* row = (LAS f32x4*)(Oacc + tid * 68);
#pragma unroll
        for (int i = 0; i < 17; ++i) row[i] = (f32x4){0.f, 0.f, 0.f, 0.f};
        lacc[tid] = 0.f;
    }
    __syncthreads();
    const float mb2 = -Mb * LOG2E;
#pragma unroll 1
    for (int seg = 0; seg < 3; ++seg) {
        const int sh = 2 * seg, L = S >> sh;
        const bf16_t* Vs = (seg == 0) ? (VT0 + (size_t)bh * 64 * S) : (VTXp + (size_t)((seg - 1) * 16 + bh) * 64 * S);
#pragma unroll 1
        for (int jq = 0; jq < 2; ++jq) {
            const int j = 2 * wave + jq, tpr = 16 >> sh, res = j / tpr, jj = j % tpr, m0 = (t0 >> sh) + 32 * jj;
            const int t = ((m0 + r) << sh) + res;
            bf16x8 qf[4];
            load_q(qf, Q0 + ((size_t)bh * S + t) * 64 + 8 * h);
            f32x16 o0, o1;
#pragma unroll
            for (int i = 0; i < 16; ++i) { o0[i] = 0.f; o1[i] = 0.f; }
            float l = 0.f;
            const int kfirst = m0 - 128;
            const float NEGI = -__builtin_inff();
            bf16x8 kf[5][4];
#pragma unroll
            for (int i = 0; i < 5; ++i) {
                const int kt = kfirst + 32 * i, ktc = kt < 0 ? 0 : kt;
                load_q(kf[i], K0 + ((size_t)bh * S + (((ktc + uperm(kperm(r), seg == 1)) << sh) + res)) * 64 + 8 * h);
            }
            f32x16 xs[5];
#pragma unroll
            for (int i = 0; i < 5; ++i) {
                const float offs = (kfirst + 32 * i < 0) ? NEGI : mb2;
#pragma unroll
                for (int e = 0; e < 16; ++e) xs[i][e] = offs;
#pragma unroll
                for (int sp = 0; sp < 4; ++sp) xs[i] = mfma32(kf[i][sp], qf[sp], xs[i]);
            }
#pragma unroll
            for (int i = 0; i < 5; ++i) {
                const int kt = kfirst + 32 * i, ktc = kt < 0 ? 0 : kt;
                bf16x8 vf[2][2];
                load_v(vf, Vs + (size_t)r * S + (size_t)res * L + ktc + 8 * h);
                float p[16];
#pragma unroll
                for (int e = 0; e < 16; ++e) {
                    float v = ex2(xs[i][e]);
                    const int c = uperm(kidx(e, h), seg == 1);
                    if ((i == 0 && c < r) || (i == 4 && c > r)) v = 0.f;
                    p[e] = v;
                }
#pragma unroll
                for (int e = 0; e < 16; ++e) l += p[e];
                pv_tile(o0, o1, vf, p);
            }
            l += shx<32>(l);
            const int tl = t - t0;
#pragma unroll
            for (int dd = 0; dd < 2; ++dd)
#pragma unroll
                for (int g = 0; g < 4; ++g) {
                    LAS f32x4* pp = (LAS f32x4*)(Oacc + tl * 68 + 32 * dd + 8 * g + 4 * h);
                    f32x4 cur = *pp;
#pragma unroll
                    for (int e = 0; e < 4; ++e) cur[e] += (dd == 0 ? o0[4 * g + e] : o1[4 * g + e]);
                    *pp = cur;
                }
            if (h == 0) lacc[tl] += l;
        }
        __syncthreads();
    }
    {
        const int t = t0 + tid; const size_t row = (size_t)(bh >> 3) * S + t; const int col0 = (bh & 7) * 64;
        const float inv = 1.0f / lacc[tid];
#pragma unroll
        for (int c8 = 0; c8 < 8; ++c8) {
            const f32x4 a0 = *(LAS f32x4*)(Oacc + tid * 68 + 8 * c8), a1 = *(LAS f32x4*)(Oacc + tid * 68 + 8 * c8 + 4);
            const bf16x8 gt = *(const bf16x8*)(G + row * DM + col0 + 8 * c8);
            f32x8 o;
#pragma unroll
            for (int e = 0; e < 4; ++e) { o[e] = a0[e] * inv * bf2f((unsigned short)gt[e]); o[4 + e] = a1[e] * inv * bf2f((unsigned short)gt[4 + e]); }
            *(bf16x8*)(Y + row * DM + col0 + 8 * c8) = pack8(o);
        }
    }
    __syncthreads();
}

#define XB_TMO      128
#define XB_XCNT(j)  (256  + 64 * (j))
#define XB_XSUB(j)  (1280 + 64 * (j))
#define XB_XGEN(j)  (2304 + 64 * (j))
#define XB_TOP      3328
#define XB_TOPGEN   3392
#define XCD_BAR_WORDS 3456
#define XB_SPIN_CAP (1u << 18)

__device__ __forceinline__ unsigned xb_ld(unsigned* p)              { return __hip_atomic_load(p, __ATOMIC_RELAXED, __HIP_MEMORY_SCOPE_AGENT); }
__device__ __forceinline__ unsigned xb_add(unsigned* p, unsigned v) { return __hip_atomic_fetch_add(p, v, __ATOMIC_RELAXED, __HIP_MEMORY_SCOPE_AGENT); }
__device__ __forceinline__ unsigned xb_xcc_id() { return (unsigned)__builtin_amdgcn_s_getreg((3 << 11) | 20) & 0xFu; }
#define XB_SPIN(cond, bar) do { unsigned _sp = 0; while (cond) { __builtin_amdgcn_s_sleep(1); \
    if ((++_sp & 255u) == 0u) { if (xb_ld(&(bar)[XB_TMO])) break; if (_sp > XB_SPIN_CAP) { atomicAdd(&(bar)[XB_TMO], 1u); break; } } } } while (0)

struct XcdBarrier {
    unsigned* bar; unsigned x;
    volatile LAS unsigned* st;
};

__device__ __forceinline__ XcdBarrier xcd_barrier_post(unsigned* bar, volatile LAS unsigned* st) {
    XcdBarrier b; b.bar = bar; b.x = xb_xcc_id(); b.st = st;
    if (threadIdx.x == 0) (void)xb_add(&bar[XB_XCNT(b.x)], 1u);
    return b;
}
__device__ __forceinline__ void xcd_barrier_complete(unsigned* bar, unsigned x, unsigned& nloc, unsigned& nx) {
    const unsigned G = gridDim.x * gridDim.y * gridDim.z;
    unsigned sum, cnt, mine, sp = 0u;
    for (;;) {
        sum = 0u; cnt = 0u; mine = 0u;
#pragma unroll
        for (unsigned j = 0; j < 16; ++j) { const unsigned c = xb_ld(&bar[XB_XCNT(j)]); sum += c; cnt += (c > 0u) ? 1u : 0u; mine = (j == x) ? c : mine; }
        if (sum == G) break;
        __builtin_amdgcn_s_sleep(1);
        if ((++sp & 255u) == 0u) { if (xb_ld(&bar[XB_TMO])) break; if (sp > XB_SPIN_CAP) { atomicAdd(&bar[XB_TMO], 1u); break; } }
    }
    nloc = mine > 0u ? mine : 1u; nx = cnt > 0u ? cnt : 1u;
}

__device__ __forceinline__ void xcd_barrier(const XcdBarrier& b) {
    asm volatile("s_waitcnt vmcnt(0)" ::: "memory");
    __syncthreads();
    if (threadIdx.x == 0) {
        unsigned* bar = b.bar;
        __builtin_amdgcn_s_waitcnt(0);
        unsigned nloc = b.st[0], nx = b.st[1];
        if (nloc == 0u) { xcd_barrier_complete(bar, b.x, nloc, nx); b.st[0] = nloc; b.st[1] = nx; }
        const unsigned old = xb_add(&bar[XB_XSUB(b.x)], 1u);
        const unsigned gen = old / nloc;
        if (old + 1u == (gen + 1u) * nloc) {
            __builtin_amdgcn_fence(__ATOMIC_RELEASE, "agent");
            asm volatile("s_waitcnt vmcnt(0)" ::: "memory");
            const unsigned og = xb_add(&bar[XB_TOP], 1u);
            const unsigned tg = og / nx;
            if (og + 1u == (tg + 1u) * nx) xb_add(&bar[XB_TOPGEN], 1u);
            else XB_SPIN(xb_ld(&bar[XB_TOPGEN]) == tg, bar);
            __builtin_amdgcn_fence(__ATOMIC_ACQUIRE, "agent");
            xb_add(&bar[XB_XGEN(b.x)], 1u);
            asm volatile("s_waitcnt vmcnt(0)" ::: "memory");
        } else {
            XB_SPIN(xb_ld(&bar[XB_XGEN(b.x)]) == gen, bar);
            __builtin_amdgcn_fence(__ATOMIC_ACQUIRE, "agent");
            asm volatile("s_waitcnt vmcnt(0)" ::: "memory");
        }
    }
    __syncthreads();
}

#ifndef REP_A
#define REP_A 1
#endif
#ifndef REP_CD
#define REP_CD 1
#endif
#ifndef REP_B
#define REP_B 1
#endif
#ifndef REP_G1
#define REP_G1 1
#endif
#ifndef REP_G2
#define REP_G2 1
#endif
#ifndef REP_N
#define REP_N 1
#endif
#ifndef REP_P
#define REP_P 1
#endif
__global__ void __launch_bounds__(512, 2) mega_fwd(Args a) {
    extern __shared__ __attribute__((aligned(16))) unsigned char lds_raw[];
    LAS unsigned char* lds = (LAS unsigned char*)lds_raw;
    cg::grid_group grid = cg::this_grid();
    if (threadIdx.x == 0) { ((volatile LAS unsigned*)(lds + 147300))[0] = 0u; ((volatile LAS unsigned*)(lds + 147300))[1] = 0u; }
    __syncthreads();
    (void)xcd_barrier_post((unsigned*)(a.ws + WS_CTL) + 12288, (volatile LAS unsigned*)(lds + 147300));
#define GSYNC() do { const __attribute__((address_space(4))) Args* ap2 = (const __attribute__((address_space(4))) Args*)__builtin_amdgcn_kernarg_segment_ptr(); asm volatile("" : "+s"(ap2)); \
        XcdBarrier xb_; xb_.bar = (unsigned*)(ap2->ws + WS_CTL) + 12288; xb_.x = xb_xcc_id(); xb_.st = (volatile LAS unsigned*)(lds + 147300); xcd_barrier(xb_); } while (0)
#define WSP(T, off) ((T*)(ws + (off)))
#define OPAQUE_WS const __attribute__((address_space(4))) Args* ap = (const __attribute__((address_space(4))) Args*)__builtin_amdgcn_kernarg_segment_ptr(); asm volatile("" : "+s"(ap)); unsigned char* ws = ap->ws; int tid = threadIdx.x; asm volatile("" : "+v"(tid)); const int lane = tid & 63, wave = __builtin_amdgcn_readfirstlane(tid >> 6); int G = gridDim.x; asm volatile("" : "+s"(G)); const int gw = blockIdx.x * 8 + wave, NGW = G * 8; (void)lane; (void)wave; (void)gw; (void)NGW
    {
        OPAQUE_WS;
        bf16_t* WinT = WSP(bf16_t, WS_WIN); bf16_t* WoutT = WSP(bf16_t, WS_WOUT); float* COS = WSP(float, WS_COS); float* SIN = WSP(float, WS_SIN);
        LAS float* scr = (LAS float*)(lds + wave * 16384);
        constexpr int I_IN = 32 * 256, I_OUT = 32 * 64, I_L = I_IN + I_OUT;
        for (int rep = 0; rep < REP_P; ++rep)
        for (int it = gw; it < NL * I_L; it += NGW) {
            const int l = it / I_L; int rr = it % I_L;
            if (rr < I_IN) {
                const int kbk = rr >> 8, nbk = rr & 255, n0 = 32 * nbk;
                const int pns = n0 >> 8, mxs = (pns & 7) >> 1, pnd = (pns & ~7) | ((((mxs & 1) << 1) | (mxs >> 1)) << 1) | (pns & 1);
                const int nd = pnd * 256 + 128 * ((n0 >> 5) & 1) + 32 * ((n0 >> 6) & 3);
                transpose_item(ap->w_in + (size_t)l * DM * NCOL, NCOL, ap->ng + l * DM, WinT + (size_t)l * NPROJ * DM, DM, 64 * kbk, n0, nd, scr, lane);
            } else {
                rr -= I_IN; const int kbk = rr >> 6, nbk = rr & 63;
                transpose_item(ap->w_out + (size_t)l * DM * DM, DM, nullptr, WoutT + (size_t)l * DM * DM, DM, 64 * kbk, 32 * nbk, 32 * nbk, scr, lane);
            }
        }
        {
            float* WF = WSP(float, WS_WF);
            for (int e = blockIdx.x * 512 + tid; e < NL * 4096; e += G * 512) {
                const int l = e >> 12, q = e & 4095, ln = q & 63, hh = (q >> 6) & 1, je = q >> 7, d = 256 * (je >> 2) + 4 * ln + (je & 3);
                const float g = ap->ng[l * DM + d];
                const f32x4 w = *(const f32x4*)(ap->w_in + (size_t)l * DM * NCOL + (size_t)d * NCOL + NPROJ + 4 * hh);
                ((f32x4*)WF)[e] = w * g;
            }
        }
        for (int e = blockIdx.x * 512 + tid; e < S * 32; e += G * 512) {
            const int pos = e >> 5, j = e & 31;
            const float ang = (float)pos * ap->inv_freq[j];
            const double rev = (double)ang * 0.15915494309189535;
            const float fr = (float)(rev - floor(rev));
            COS[e] = __builtin_amdgcn_cosf(fr); SIN[e] = __builtin_amdgcn_sinf(fr);
        }
    }

#pragma unroll 1
    for (int l = 0; l < NL; ++l) {
        {
            OPAQUE_WS;
            bf16_t* XB = WSP(bf16_t, WS_XB); float* LOGF = WSP(float, WS_LOGF);
            const float* src = (l == 0) ? ap->x : ap->out;
            if (l == 0) grid.sync();
            {
                const f32x4* WFg = (const f32x4*)WSP(float, WS_WF) + (size_t)l * 4096;
                LAS f32x4* wfl = (LAS f32x4*)lds;
#pragma unroll
                for (int i = 0; i < 8; ++i) wfl[tid + 512 * i] = WFg[tid + 512 * i];
                __syncthreads();
            }
            for (int rep = 0; rep < REP_N; ++rep)
            for (int m = gw; m < MT; m += NGW) {
                const int b = m / S, s = m % S;
                norm_row(src + (size_t)m * DM, (const LAS f32x4*)lds, ap->fb + l * 8, XB + (size_t)m * DM, LOGF + (size_t)b * 8 * S, s, lane);
            }
        }
        GSYNC();
        if (blockIdx.x < 16) {
            OPAQUE_WS;
            float* LOGF = WSP(float, WS_LOGF); float* FB = WSP(float, WS_F);
            const int bh = blockIdx.x;
            const float* lf = LOGF + (size_t)bh * S + tid * 16;
            float v[16];
#pragma unroll
            for (int i = 0; i < 4; ++i) { const f32x4 t = ((const f32x4*)lf)[i]; v[4 * i] = t[0]; v[4 * i + 1] = t[1]; v[4 * i + 2] = t[2]; v[4 * i + 3] = t[3]; }
            double tot = 0.0;
#pragma unroll
            for (int i = 0; i < 16; ++i) tot += (double)v[i];
            double inc = tot;
#pragma unroll
            for (int o = 1; o < 64; o <<= 1) { const double t = __shfl_up(inc, o); if (lane >= o) inc += t; }
            LAS double* wt = (LAS double*)lds;
            if (lane == 63) wt[wave] = inc;
            __syncthreads();
            double base = inc - tot;
            for (int w = 0; w < wave; ++w) base += wt[w];
            float* fo = FB + (size_t)bh * S + tid * 16;
            double run = base;
#pragma unroll
            for (int i = 0; i < 4; ++i) { f32x4 t; for (int e = 0; e < 4; ++e) { run += (double)v[4 * i + e]; t[e] = (float)run; } ((f32x4*)fo)[i] = t; }
            __syncthreads();
        }
        {
            OPAQUE_WS;
            bf16_t* WinT = WSP(bf16_t, WS_WIN); bf16_t* XB = WSP(bf16_t, WS_XB); bf16_t* Qb = WSP(bf16_t, WS_Q); bf16_t* Kb = WSP(bf16_t, WS_K); bf16_t* VT = WSP(bf16_t, WS_VT); bf16_t* VTX = WSP(bf16_t, WS_VTX);
            bf16_t* Gb = WSP(bf16_t, WS_G); float* KMP = WSP(float, WS_KMP); float* COS = WSP(float, WS_COS); float* SIN = WSP(float, WS_SIN);
            pg8::Gemm g{XB, WinT + (size_t)l * NPROJ * DM, MT, NPROJ, DM}; pg8::StaticOrder So; So.init(MT, NPROJ, G, (int)blockIdx.x);
            EpiIn E{Qb, Kb, VT, VTX, Gb, KMP, ap->qg + l * 192, ap->kg + l * 192, COS, SIN};
            for (int rep = 0; rep < REP_G1; ++rep) pg8::gemm_phase<EpiIn, pg8::StaticOrder, true, true>(lds, g, So, E);
        }
        GSYNC();
        {
            OPAQUE_WS;
            unsigned* ctl = WSP(unsigned, WS_CTL); bf16_t* Qb = WSP(bf16_t, WS_Q); bf16_t* Kb = WSP(bf16_t, WS_K); bf16_t* VT = WSP(bf16_t, WS_VT); bf16_t* VTX = WSP(bf16_t, WS_VTX);
            bf16_t* Gb = WSP(bf16_t, WS_G); bf16_t* Yb = WSP(bf16_t, WS_Y); float* FB = WSP(float, WS_F); float* KMP = WSP(float, WS_KMP);
            float Mx[3];
#pragma unroll
            for (int gi = 0; gi < 3; ++gi) {
                const float gq = wave_max(fabsf(ap->qg[l * 192 + gi * 64 + lane])), gk = wave_max(fabsf(ap->kg[l * 192 + gi * 64 + lane]));
                Mx[gi] = 8.1f * gq * gk;
            }
            LAS float* Oacc = (LAS float*)lds; LAS float* lacc = (LAS float*)(lds + 512 * 68 * 4);
            const int xcc = (int)(__builtin_amdgcn_s_getreg((3 << 11) | 20) & 7u);
            const int vb = (G == 256) ? ((int)(blockIdx.x & 7) * 32 + (int)(blockIdx.x >> 3)) : (int)blockIdx.x;
            for (int rep = 0; rep < REP_A; ++rep)
            for (int it = vb; it < 256; it += G)
                attn_A_item(Qb, Kb, VT, VTX, Gb, Yb, it >> 4, it & 15, Mx[0], Oacc, lacc, tid, wave, lane);
            for (int rep = 0; rep < REP_CD; ++rep) {
                LAS int* qw = (LAS int*)(lds + 147200);
                for (int sq = 0; sq < 8; ++sq) {
                    const int q = (xcc + sq) & 7;
                    unsigned* ctr = ctl + 64 * (l * 16 + q) + 1024 * 4 * rep;
                    for (;;) {
                        if (tid == 0) *qw = (int)atomicAdd(ctr, 1u);
                        __syncthreads();
                        const int idx = __builtin_amdgcn_readfirstlane(*qw);
                        __syncthreads();
                        if (idx >= 72) break;
                        const int k = idx >> 2, j = idx & 3, bh = 2 * q + (j >> 1), halfq = (k >= 6 && k < 10), qb2 = k < 6 ? 13 - k : (halfq ? 37 - k : 17 - k);
                        if (j & 1) attn_wg2_item<3>(Qb + (size_t)3 * 16 * S * 64, Kb + (size_t)3 * 16 * S * 64, VT + (size_t)3 * 16 * 64 * S, FB + (size_t)bh * S, nullptr, Gb, Yb, bh, qb2, halfq, 3, Mx[2], lds, tid, wave, lane);
                        else attn_wg2_item<2>(Qb + (size_t)2 * 16 * S * 64, Kb + (size_t)2 * 16 * S * 64, VT + (size_t)2 * 16 * 64 * S, nullptr, KMP + (size_t)bh * 32 * 2 * 64, Gb, Yb, bh, qb2, halfq, 2, Mx[1], lds, tid, wave, lane);
                    }
                }
            }
            for (int rep = 0; rep < REP_B; ++rep) {
                LAS int* qw = (LAS int*)(lds + 147200);
                for (int sq = 0; sq < 8; ++sq) {
                    const int q = (xcc + sq) & 7;
                    unsigned* ctr = ctl + 64 * (l * 16 + 8 + q) + 1024 * 4 * rep;
                    for (;;) {
                        if (tid == 0) *qw = (int)atomicAdd(ctr, 1u);
                        __syncthreads();
                        const int idx = __builtin_amdgcn_readfirstlane(*qw);
                        __syncthreads();
                        if (idx >= 64) break;
                        const int qb = 31 - (idx >> 1), bh = 2 * q + (idx & 1);
                        attn_wgB_item(Qb + (size_t)1 * 16 * S * 64, Kb + (size_t)1 * 16 * S * 64, VT + (size_t)1 * 16 * 64 * S, Gb, Yb, bh, qb, 1, lds, tid, wave, lane);
                    }
                }
            }
        }
        GSYNC();
        {
            OPAQUE_WS;
            bf16_t* WoutT = WSP(bf16_t, WS_WOUT); bf16_t* Yb = WSP(bf16_t, WS_Y);
            pg8::Gemm g{Yb, WoutT + (size_t)l * DM * DM, MT, DM, DM}; pg8::StaticOrder So; So.init(MT, DM, G, (int)blockIdx.x);
            EpiOut E{(l == 0) ? ap->x : ap->out, ap->out};
            for (int rep = 0; rep < (REP_G2 > 1 && l == 0 ? REP_G2 : 1); ++rep) pg8::gemm_phase<EpiOut, pg8::StaticOrder, true, true>(lds, g, So, E);
        }
        if (l + 1 < NL) GSYNC();
    }
}

extern "C" void kernel_launch(void* const* d_in, const int* in_sizes, int n_in, void* d_out, int out_size, void* d_ws, size_t ws_size, hipStream_t stream) {
    static int grid = 0;
    if (grid == 0) {
        if (n_in != 7 || out_size != MT * DM || ws_size < WS_END) { fprintf(stderr, "kernel_launch: unexpected shapes (n_in %d out %d ws %zu)\n", n_in, out_size, ws_size); grid = -1; return; }
        int dev = 0, cus = 0, per_cu = 0;
        hipGetDevice(&dev); hipDeviceGetAttribute(&cus, hipDeviceAttributeMultiprocessorCount, dev);
        if (hipFuncSetAttribute((const void*)mega_fwd, hipFuncAttributeMaxDynamicSharedMemorySize, LDS_BYTES) != hipSuccess) { fprintf(stderr, "kernel_launch: hipFuncSetAttribute failed\n"); grid = -1; return; }
        if (hipOccupancyMaxActiveBlocksPerMultiprocessor(&per_cu, (const void*)mega_fwd, 512, LDS_BYTES) != hipSuccess || per_cu < 1) { fprintf(stderr, "kernel_launch: occupancy query says %d\n", per_cu); per_cu = 1; }
        (void)hipGetLastError();
        grid = cus * per_cu;
    }
    if (grid < 0) return;
    hipMemsetAsync((char*)d_ws + WS_CTL, 0, CTL_BYTES, stream);
    Args a{};
    a.x = (const float*)d_in[0]; a.ng = (const float*)d_in[1]; a.w_in = (const float*)d_in[2]; a.qg = (const float*)d_in[3]; a.kg = (const float*)d_in[4];
    a.fb = (const float*)d_in[5]; a.w_out = (const float*)d_in[6]; a.out = (float*)d_out; a.ws = (unsigned char*)d_ws;
    for (int j = 0; j < 32; ++j) a.inv_freq[j] = (float)(1.0 / pow(10000.0, (double)j / 32.0));
    void* args[] = {&a};
    hipError_t e = hipLaunchCooperativeKernel((const void*)mega_fwd, dim3(grid), dim3(512), args, LDS_BYTES, stream);
    if (e != hipSuccess) fprintf(stderr, "kernel_launch: cooperative launch failed: %s (grid %d)\n", hipGetErrorString(e), grid);
}
```
